# Optimizing an MI355X kernel written in HIP

```python
import jax, jax.numpy as jnp
from jax import lax
import numpy as np

D_MODEL = 2048
BATCH = 1
SEQ = 16384
DEPTH = 4

N_MIXERS = 3
N_POOL_LAYERS = (DEPTH + 2) // 3
N_SGU_LAYERS = (DEPTH + 1) // 3
N_ATTN_LAYERS = DEPTH // 3
RMS_EPS = 1e-6
D_FF = 4 * D_MODEL

POOL_WINDOWS = (2, 4, 8, 16)
POOL_N_GROUPS = len(POOL_WINDOWS)
POOL_GROUP_CH = D_MODEL // POOL_N_GROUPS

SGU_WIDTH = D_MODEL
SGU_CHUNK = 128
SGU_GROUPS = 8
SGU_GROUP_CH = SGU_WIDTH // SGU_GROUPS

ATTN_PATTERNS = ((128, 1), (512, 4), (2048, 16))
ATTN_GROUPS = len(ATTN_PATTERNS)
ATTN_HEADS = 8
HEAD_DIM = 128
ATTN_BLOCK = 128
ATTN_OUT_WIDTH = ATTN_HEADS * HEAD_DIM
ATTN_QKV_WIDTH = 3 * ATTN_GROUPS * ATTN_HEADS * HEAD_DIM
NEG_INF = -1e30

kernel_name = "hybrid_pool_sgu_dilated_attn_trunk"


def rmsnorm(x, gain):
    xf = x.astype(jnp.float32)
    y = xf * lax.rsqrt(jnp.mean(xf * xf, axis=-1, keepdims=True) + RMS_EPS)
    return (y * gain.astype(jnp.float32)).astype(x.dtype)


def pool_mixer(x, w_in, w_group, scale, w_out):
    B, S, _ = x.shape
    h = (x @ w_in).astype(jnp.float32).reshape(B, S, POOL_N_GROUPS, POOL_GROUP_CH)
    cs = jnp.cumsum(h, axis=1)
    pos = jnp.arange(S)
    outs = []
    for g, w in enumerate(POOL_WINDOWS):
        c = cs[:, :, g]
        c_prev = jnp.pad(c, ((0, 0), (w, 0), (0, 0)))[:, :S]
        count = jnp.minimum(pos + 1, w).astype(jnp.float32)[None, :, None]
        outs.append((c - c_prev) / count - h[:, :, g])
    pooled = jnp.stack(outs, axis=2)
    mixed = jnp.einsum('bsgc,gcd->bsgd', pooled, w_group.astype(jnp.float32))
    mixed = mixed.reshape(B, S, D_MODEL) * scale.astype(jnp.float32)
    return mixed.astype(x.dtype) @ w_out


def sgu_mixer(x, w_in, v_norm, w_s, b_s, w_out):
    B, S, _ = x.shape
    h = jax.nn.gelu(x @ w_in, approximate=False)
    u, v = jnp.split(h, 2, axis=-1)
    v = rmsnorm(v, v_norm)
    n_chunks = S // SGU_CHUNK
    vc = v.reshape(B, n_chunks, SGU_CHUNK, SGU_GROUPS, SGU_GROUP_CH)
    causal = jnp.tril(jnp.ones((SGU_CHUNK, SGU_CHUNK), dtype=bool))
    ws = jnp.where(causal[None], w_s, jnp.zeros_like(w_s))
    sp = jnp.einsum('gts,bnsgc->bntgc', ws, vc) + b_s.T[None, None, :, :, None]
    gated = u * sp.reshape(B, S, SGU_WIDTH)
    return gated @ w_out


def dilated_group_attention(q, k, v, window, dilation):
    B, S, H, Dh = q.shape
    n_keys = window // dilation + 1
    scale = HEAD_DIM ** -0.5
    k_pad = jnp.pad(k, ((0, 0), (window, 0), (0, 0), (0, 0)))
    v_pad = jnp.pad(v, ((0, 0), (window, 0), (0, 0), (0, 0)))
    qi = jnp.arange(ATTN_BLOCK)
    kj = jnp.arange(n_keys)
    offsets = qi[:, None] - dilation * kj[None, :]
    local_idx = window + offsets

    def block(blk):
        s0 = blk * ATTN_BLOCK
        qb = lax.dynamic_slice_in_dim(q, s0, ATTN_BLOCK, axis=1).astype(jnp.float32)
        kw = lax.dynamic_slice_in_dim(k_pad, s0, window + ATTN_BLOCK, axis=1)
        vw = lax.dynamic_slice_in_dim(v_pad, s0, window + ATTN_BLOCK, axis=1)
        kg = kw[:, local_idx].astype(jnp.float32)
        vg = vw[:, local_idx].astype(jnp.float32)
        s = jnp.einsum('bqhd,bqjhd->bhqj', qb, kg) * scale
        valid = (s0 + offsets) >= 0
        s = jnp.where(valid[None, None], s, jnp.float32(NEG_INF))
        m = jnp.max(s, axis=-1, keepdims=True)
        p = jnp.exp(s - m)
        den = jnp.sum(p, axis=-1, keepdims=True)
        o = jnp.einsum('bhqj,bqjhd->bqhd', p, vg)
        o = o / jnp.moveaxis(den[..., 0], 1, 2)[..., None]
        lse = jnp.moveaxis((m + jnp.log(den))[..., 0], 1, 2)
        return o, lse

    outs, lses = lax.map(block, jnp.arange(S // ATTN_BLOCK))
    o = jnp.moveaxis(outs, 0, 1).reshape(B, S, H, Dh)
    lse = jnp.moveaxis(lses, 0, 1).reshape(B, S, H)
    return o, lse


def attn_mixer(x, w_qkv, w_out):
    B, S, _ = x.shape
    qkv = (x @ w_qkv).reshape(B, S, 3, ATTN_GROUPS, ATTN_HEADS, HEAD_DIM)
    outs, lses = [], []
    for g, (window, dilation) in enumerate(ATTN_PATTERNS):
        o, lse = dilated_group_attention(qkv[:, :, 0, g], qkv[:, :, 1, g], qkv[:, :, 2, g],
                                         window, dilation)
        outs.append(o)
        lses.append(lse)
    weights = jax.nn.softmax(jnp.stack(lses, axis=0), axis=0)
    o = jnp.sum(weights[..., None] * jnp.stack(outs, axis=0), axis=0)
    return o.reshape(B, S, ATTN_OUT_WIDTH).astype(x.dtype) @ w_out


def squared_relu_mlp(x, w_up, w_down):
    h = jax.nn.relu(x @ w_up)
    return (h * h) @ w_down


def setup_inputs(seed: int = 0) -> dict:
    key = jax.random.key(seed)
    ks = jax.random.split(key, 20)
    f32 = jnp.float32

    def nrm(k, shape, fan_in):
        return jax.random.normal(k, shape, f32) * (fan_in ** -0.5)

    def gain(k, shape):
        return 1.0 + 0.05 * jax.random.normal(k, shape, f32)

    x = jax.random.normal(ks[0], (BATCH, SEQ, D_MODEL), f32)
    norm_mix = gain(ks[1], (DEPTH, D_MODEL))
    pool_w_in = nrm(ks[2], (N_POOL_LAYERS, D_MODEL, D_MODEL), D_MODEL)
    pool_w_group = nrm(ks[3], (N_POOL_LAYERS, POOL_N_GROUPS, POOL_GROUP_CH, POOL_GROUP_CH), POOL_GROUP_CH)
    pool_scale = gain(ks[4], (N_POOL_LAYERS, D_MODEL))
    pool_w_out = nrm(ks[5], (N_POOL_LAYERS, D_MODEL, D_MODEL), D_MODEL)
    sgu_w_in = nrm(ks[6], (N_SGU_LAYERS, D_MODEL, 2 * SGU_WIDTH), D_MODEL)
    sgu_v_norm = gain(ks[7], (N_SGU_LAYERS, SGU_WIDTH))
    sgu_w_s = nrm(ks[8], (N_SGU_LAYERS, SGU_GROUPS, SGU_CHUNK, SGU_CHUNK), SGU_CHUNK)
    sgu_b_s = 1.0 + 0.1 * jax.random.normal(ks[9], (N_SGU_LAYERS, SGU_GROUPS, SGU_CHUNK), f32)
    sgu_w_out = nrm(ks[10], (N_SGU_LAYERS, SGU_WIDTH, D_MODEL), SGU_WIDTH)
    attn_w_qkv = nrm(ks[11], (N_ATTN_LAYERS, D_MODEL, ATTN_QKV_WIDTH), D_MODEL)
    attn_w_out = nrm(ks[12], (N_ATTN_LAYERS, ATTN_OUT_WIDTH, D_MODEL), ATTN_OUT_WIDTH)
    norm_mlp = gain(ks[13], (DEPTH, D_MODEL))
    mlp_w_up = nrm(ks[14], (DEPTH, D_MODEL, D_FF), D_MODEL)
    mlp_w_down = nrm(ks[15], (DEPTH, D_FF, D_MODEL), D_FF)
    norm_final = gain(ks[16], (D_MODEL,))
    return {"x": x, "norm_mix": norm_mix,
            "pool_w_in": pool_w_in, "pool_w_group": pool_w_group,
            "pool_scale": pool_scale, "pool_w_out": pool_w_out,
            "sgu_w_in": sgu_w_in, "sgu_v_norm": sgu_v_norm, "sgu_w_s": sgu_w_s,
            "sgu_b_s": sgu_b_s, "sgu_w_out": sgu_w_out,
            "attn_w_qkv": attn_w_qkv, "attn_w_out": attn_w_out,
            "norm_mlp": norm_mlp, "mlp_w_up": mlp_w_up, "mlp_w_down": mlp_w_down,
            "norm_final": norm_final}


def reference(x, norm_mix, pool_w_in, pool_w_group, pool_scale, pool_w_out,
              sgu_w_in, sgu_v_norm, sgu_w_s, sgu_b_s, sgu_w_out,
              attn_w_qkv, attn_w_out, norm_mlp, mlp_w_up, mlp_w_down, norm_final):
    for i in range(DEPTH):
        kind = i % N_MIXERS
        j = i // N_MIXERS
        h = rmsnorm(x, norm_mix[i])
        if kind == 0:
            y = pool_mixer(h, pool_w_in[j], pool_w_group[j], pool_scale[j], pool_w_out[j])
        elif kind == 1:
            y = sgu_mixer(h, sgu_w_in[j], sgu_v_norm[j], sgu_w_s[j], sgu_b_s[j], sgu_w_out[j])
        else:
            y = attn_mixer(h, attn_w_qkv[j], attn_w_out[j])
        x = x + y.astype(x.dtype)
        h = rmsnorm(x, norm_mlp[i])
        x = x + squared_relu_mlp(h, mlp_w_up[i], mlp_w_down[i]).astype(x.dtype)
    return rmsnorm(x, norm_final)
```

```cpp
#include <hip/hip_runtime.h>
#include <hip/hip_cooperative_groups.h>
#include <cstdio>
#include <cstdint>
namespace cg = cooperative_groups;

#define LAS __attribute__((address_space(3)))
typedef unsigned short bf16_t;
typedef short bf16x8 __attribute__((ext_vector_type(8)));
typedef float f32x4 __attribute__((ext_vector_type(4)));
typedef float f32x2 __attribute__((ext_vector_type(2)));
typedef unsigned u32x4 __attribute__((ext_vector_type(4)));
typedef unsigned u32x2 __attribute__((ext_vector_type(2)));

constexpr int SEQ = 16384, DM = 2048, DFF = 8192;
constexpr float RMS_EPS = 1e-6f;

constexpr size_t OFF_BAR = 0;
constexpr size_t OFF_VSS = 16384;
constexpr size_t OFF_SS = OFF_VSS + (size_t)SEQ * 32 * 4;
constexpr size_t OFF_LSE = OFF_SS + (size_t)8 * SEQ * 32 * 4;
constexpr size_t OFF_W = OFF_LSE + (size_t)3 * SEQ * 8 * 4;
constexpr size_t WPI = 0;
constexpr size_t WPG = WPI + (size_t)2 * 2048 * 2048;
constexpr size_t WPO = WPG + (size_t)2 * 2048 * 512;
constexpr size_t WSI = WPO + (size_t)2 * 2048 * 2048;
constexpr size_t WSO = WSI + (size_t)4096 * 2048;
constexpr size_t WQKV = WSO + (size_t)2048 * 2048;
constexpr size_t WAO = WQKV + (size_t)9216 * 2048;
constexpr size_t WUP = WAO + (size_t)2048 * 1024;
constexpr size_t WDN = WUP + (size_t)4 * 8192 * 2048;
constexpr size_t WEND = WDN + (size_t)4 * 8192 * 2048;
constexpr size_t OFF_H = OFF_W + WEND * 2;
constexpr size_t OFF_T1 = OFF_H + (size_t)SEQ * 2048 * 2;
constexpr size_t OFF_T2 = OFF_T1 + (size_t)SEQ * 9216 * 2;
constexpr size_t WS_END = OFF_T2 + (size_t)3 * SEQ * 1024 * 2;
constexpr size_t LDS_BYTES = 143360;

struct Params {
    const float *x, *norm_mix, *pool_w_in, *pool_w_group, *pool_scale, *pool_w_out, *sgu_w_in, *sgu_v_norm, *sgu_w_s, *sgu_b_s, *sgu_w_out,
        *attn_w_qkv, *attn_w_out, *norm_mlp, *mlp_w_up, *mlp_w_down, *norm_final;
    float* out;
    unsigned char* ws;
};

__device__ __forceinline__ unsigned cvt_pk_bf16(float lo, float hi) { unsigned r; asm volatile("v_cvt_pk_bf16_f32 %0, %1, %2" : "=v"(r) : "v"(lo), "v"(hi)); return r; }
__device__ __forceinline__ float bf_lo(unsigned w) { return __uint_as_float(w << 16); }
__device__ __forceinline__ float bf_hi(unsigned w) { return __uint_as_float(w & 0xffff0000u); }
__device__ __forceinline__ float bf2f(bf16_t b) { return __uint_as_float(((unsigned)b) << 16); }
__device__ __forceinline__ bf16_t f2bf(float f) { return (bf16_t)(cvt_pk_bf16(f, 0.f) & 0xffffu); }

__device__ __forceinline__ int tid_fresh() { int t = threadIdx.x; asm volatile("" : "+v"(t)); return t; }
__device__ __forceinline__ int bid_fresh() { int b = blockIdx.x; asm volatile("" : "+s"(b)); return b; }
__device__ __forceinline__ int gdim_fresh() { int g = gridDim.x; asm volatile("" : "+s"(g)); return g; }

__device__ __forceinline__ f32x2 gelu_pk(f32x2 v) {
    const f32x2 av = __builtin_elementwise_abs(v), d = av * 0.2316418882f + 1.0f;
    f32x2 t; t.x = __builtin_amdgcn_rcpf(d.x); t.y = __builtin_amdgcn_rcpf(d.y);
    f32x2 q = t * 0.5307027145f + (-0.7265760135f); q = q * t + 0.7107068705f; q = q * t + (-0.142248368f); q = q * t + 0.127414796f; q = q * t;
    const f32x2 s = (v * v) * (-0.72134752044f);
    f32x2 e; e.x = __builtin_amdgcn_exp2f(s.x); e.y = __builtin_amdgcn_exp2f(s.y);
    const f32x2 m = v * (q * e), r = v - m;
    f32x2 o; o.x = v.x < 0.f ? m.x : r.x; o.y = v.y < 0.f ? m.y : r.y; return o;
}

namespace pg8 {
constexpr int BM = 256, BK = 64, HALF = 128, HTB = HALF * BK * 2, STAGE_BYTES = 8 * HTB, NXCD = 8, WGM = 8;
__device__ __forceinline__ int lds_byte(int r, int c) { const int st = (r >> 4) * 2 + (c >> 5), rr = r & 15, cc = c & 31, ob = rr * 64 + cc * 2; return st * 1024 + (ob ^ (((ob >> 9) & 1) << 5)); }
__device__ __forceinline__ void stage_rc(int b, int& R, int& C) { const int st = b / 1024, sb = b % 1024, swz = sb ^ (((sb >> 9) & 1) << 5); R = (st >> 1) * 16 + swz / 64; C = (st & 1) * 32 + (swz % 64) / 2; }
__device__ __forceinline__ int perm32(int rho) { const int n = rho >> 4, i = rho & 15; return 8 * (i >> 2) + 4 * n + (i & 3); }

struct Unit { int pm, pn; };
struct Gemm { const bf16_t* A; const bf16_t* Bt; int M, N, K, lda, agrp; };

struct StaticOrder {
    int nM, nN, nwg, G, c;
    __device__ void init(int M, int N, int G_, int c_) { nM = M / BM; nN = N / BM; nwg = nM * nN; G = G_; c = c_; }
    __device__ bool next(int i, Unit& u) const {
        const long L = (long)i * G + c; if (L >= nwg) return false;
        int wgid = (int)L; { const int q = nwg / NXCD, r = nwg % NXCD, xcd = wgid % NXCD, off = wgid / NXCD; wgid = (xcd < r ? xcd * (q + 1) : r * (q + 1) + (xcd - r) * q) + off; }
        const int nig = WGM * nN, gid = wgid / nig, fm = gid * WGM, gsz = (nM - fm) < WGM ? (nM - fm) : WGM;
        u.pm = fm + ((wgid % nig) % gsz); u.pn = (wgid % nig) / gsz; return true;
    }
};

enum { ACT_NONE = 0, ACT_GELU_VSS = 1, ACT_RELU2 = 2, ACT_COLSCALE = 3 };
struct EpiBf16 {
    static constexpr bool PERM = true;
    bf16_t* O; int ldc; int act; const float* colscale; float* vss; const float* ss;
    __device__ __forceinline__ void operator()(const f32x4 (&acc)[2][2][4][2], const Unit& u, int wr, int wc, int fr, int fq) const {
        const int row0 = u.pm * BM + wr * 64 + fr, col0 = u.pn * BM + wc * 32 + 8 * fq;
        const bool do_vss = (act == ACT_GELU_VSS) && (u.pn * BM >= 2048);
        float rsv[8];
#pragma unroll
        for (int gi = 0; gi < 8; ++gi) rsv[gi] = 1.0f;
        if (this->ss) {
#pragma unroll
            for (int hb = 0; hb < 2; ++hb) {
                f32x4 p0[4], p1[4];
#pragma unroll
                for (int m = 0; m < 4; ++m) { const float* pp = this->ss + (size_t)(row0 + hb * HALF + m * 16) * 32 + fq * 8; p0[m] = *(const f32x4*)pp; p1[m] = *(const f32x4*)(pp + 4); }
#pragma unroll
                for (int m = 0; m < 4; ++m) {
                    float t = ((p0[m][0] + p0[m][1]) + (p0[m][2] + p0[m][3])) + ((p1[m][0] + p1[m][1]) + (p1[m][2] + p1[m][3]));
                    t += __shfl_xor(t, 16); t += __shfl_xor(t, 32);
                    rsv[hb * 4 + m] = 1.0f / sqrtf(t * (1.0f / DM) + RMS_EPS);
                }
            }
        }
#pragma unroll
        for (int ai = 0; ai < 2; ++ai)
#pragma unroll
            for (int m = 0; m < 4; ++m) {
                const int row = row0 + ai * HALF + m * 16;
                bf16_t* rowp = O + (size_t)row * ldc + col0;
                float ss = 0.f;
                const float rs = rsv[ai * 4 + m];
#pragma unroll
                for (int bj = 0; bj < 2; ++bj) {
                    f32x4 v0 = acc[ai][bj][m][0] * rs, v1 = acc[ai][bj][m][1] * rs;
                    if (act == ACT_GELU_VSS) {
                        f32x2 a = gelu_pk((f32x2){v0[0], v0[1]}), b = gelu_pk((f32x2){v0[2], v0[3]}), c = gelu_pk((f32x2){v1[0], v1[1]}), d = gelu_pk((f32x2){v1[2], v1[3]});
                        v0 = (f32x4){a.x, a.y, b.x, b.y}; v1 = (f32x4){c.x, c.y, d.x, d.y};
                        ss += (v0[0] * v0[0] + v0[1] * v0[1]) + (v0[2] * v0[2] + v0[3] * v0[3]) + (v1[0] * v1[0] + v1[1] * v1[1]) + (v1[2] * v1[2] + v1[3] * v1[3]);
                    } else if (act == ACT_RELU2) {
#pragma unroll
                        for (int j = 0; j < 4; ++j) { const float a = fmaxf(v0[j], 0.f), b = fmaxf(v1[j], 0.f); v0[j] = a * a; v1[j] = b * b; }
                    } else if (act == ACT_COLSCALE) {
                        v0 = v0 * *(const f32x4*)(colscale + col0 + bj * HALF); v1 = v1 * *(const f32x4*)(colscale + col0 + bj * HALF + 4);
                    }
                    u32x4 w; w.x = cvt_pk_bf16(v0[0], v0[1]); w.y = cvt_pk_bf16(v0[2], v0[3]); w.z = cvt_pk_bf16(v1[0], v1[1]); w.w = cvt_pk_bf16(v1[2], v1[3]);
                    *(u32x4*)(rowp + bj * HALF) = w;
                }
                if (do_vss) { ss += __shfl_xor(ss, 16); ss += __shfl_xor(ss, 32); if (fq == 0) vss[(size_t)row * 32 + (u.pn - 8) * 4 + wc] = ss; }
            }
    }
};
struct EpiResid {
    static constexpr bool PERM = false;
    const float* xin; float* out; int ldc; bf16_t* xb; float* ss;
    __device__ __forceinline__ void operator()(const f32x4 (&acc)[2][2][4][2], const Unit& u, int wr, int wc, int fr, int fq) const {
        const int row0 = u.pm * BM + wr * 64 + fr, col0 = u.pn * BM + wc * 32 + 4 * fq;
        f32x4 bs[2][4];
#pragma unroll
        for (int q = 0; q < 4; ++q) bs[0][q] = *(const f32x4*)(xin + (size_t)row0 * ldc + col0 + (q >> 1) * HALF + (q & 1) * 16);
#pragma unroll
        for (int gi = 0; gi < 8; ++gi) {
            const int ai = gi >> 2, m = gi & 3;
            const int row = row0 + ai * HALF + m * 16;
            const size_t off = (size_t)row * ldc + col0;
            if (gi + 1 < 8) {
                const size_t offn = (size_t)(row0 + ((gi + 1) >> 2) * HALF + ((gi + 1) & 3) * 16) * ldc + col0;
#pragma unroll
                for (int q = 0; q < 4; ++q) bs[(gi + 1) & 1][q] = *(const f32x4*)(xin + offn + (q >> 1) * HALF + (q & 1) * 16);
            }
            float sq = 0.f;
#pragma unroll
            for (int q = 0; q < 4; ++q) {
                const int bj = q >> 1, n = q & 1;
                const f32x4 o = bs[gi & 1][q] + acc[ai][bj][m][n];
                *(f32x4*)(out + off + bj * HALF + n * 16) = o;
                if (ss) {
                    u32x2 w; w.x = cvt_pk_bf16(o[0], o[1]); w.y = cvt_pk_bf16(o[2], o[3]);
                    *(u32x2*)(xb + off + bj * HALF + n * 16) = w;
                    sq += (o[0] * o[0] + o[1] * o[1]) + (o[2] * o[2] + o[3] * o[3]);
                }
            }
            if (ss) { sq += __shfl_xor(sq, 16); sq += __shfl_xor(sq, 32); if (fq == 0) ss[(size_t)row * 32 + u.pn * 4 + wc] = sq; }
        }
    }
};

template <class Epi>
__device__ __forceinline__ void gemm_phase(LAS unsigned char* lds, const Gemm g, const StaticOrder& S, const Epi& E) {
    const int tid = tid_fresh(), wid = __builtin_amdgcn_readfirstlane(tid >> 6), lane = tid & 63, wr = wid >> 2, wc = wid & 3, fr = lane & 15, fq = lane >> 4;
    const int K = g.K, nt = K / BK, lda = g.lda;
    unsigned voffA[2], voffB[2];
#pragma unroll
    for (int i = 0; i < 2; ++i) { int R, C; stage_rc(tid * 16 + i * 8192, R, C); const int Rb = Epi::PERM ? ((R & ~31) + perm32(R & 31)) : R;
        voffA[i] = (unsigned)(R * lda + C) * 2u; voffB[i] = (unsigned)(Rb * K + C) * 2u; }
    const size_t kstep = (size_t)(BK * 2);
    const size_t hA = (size_t)HALF * lda * 2, hB = (size_t)HALF * K * 2;
    const size_t tA = 2 * hA, tB = 2 * hB;
    const unsigned ldsw = (unsigned)wid * 1024u;
    const int aoff = lds_byte(wr * 64 + fr, fq * 8), boff = lds_byte(wc * 32 + fr, fq * 8);
#define PG8_SA(b, h) (((b) * 2 + (h)) * HTB)
#define PG8_SB(b, h) ((4 + (b) * 2 + (h)) * HTB)
#define PG8_STAGE(bufoff, gbase, voff) do { _Pragma("unroll") for (int _i = 0; _i < 2; ++_i) \
        __builtin_amdgcn_global_load_lds((const unsigned*)((const char*)(gbase) + (voff)[_i]), (LAS unsigned*)(lds + (bufoff) + ldsw + _i * 8192), 16, 0, 0); } while (0)
#define PG8_LDA(dst, b, h) do { _Pragma("unroll") for (int m = 0; m < 4; ++m) _Pragma("unroll") for (int k = 0; k < 2; ++k) dst[m][k] = *(const LAS bf16x8*)(lds + PG8_SA(b, h) + aoff + m * 2048 + k * 1024); } while (0)
#define PG8_LDB(dst, b, h) do { _Pragma("unroll") for (int n = 0; n < 2; ++n) _Pragma("unroll") for (int k = 0; k < 2; ++k) dst[n][k] = *(const LAS bf16x8*)(lds + PG8_SB(b, h) + boff + n * 2048 + k * 1024); } while (0)
#define PG8_MMA(ai, bj, At, Bt) do { __builtin_amdgcn_s_setprio(1); _Pragma("unroll") for (int m = 0; m < 4; ++m) _Pragma("unroll") for (int n = 0; n < 2; ++n) _Pragma("unroll") for (int k = 0; k < 2; ++k) \
        acc[ai][bj][m][n] = __builtin_amdgcn_mfma_f32_16x16x32_bf16(Bt[n][k], At[m][k], acc[ai][bj][m][n], 0, 0, 0); __builtin_amdgcn_s_setprio(0); } while (0)
#define PG8_WAIT_V(n) asm volatile("s_waitcnt vmcnt(" #n ")" ::: "memory")
#define PG8_WAIT_L(n) asm volatile("s_waitcnt lgkmcnt(" #n ")" ::: "memory")
#define PG8_BAR __builtin_amdgcn_s_barrier()
#define PG8_SCHED __builtin_amdgcn_sched_barrier(0)
    Unit cur, nxt; int ui = 0;
    if (!S.next(0, cur)) return;
    f32x4 acc[2][2][4][2];
#pragma unroll
    for (int a = 0; a < 2; ++a)
#pragma unroll
        for (int b = 0; b < 2; ++b)
#pragma unroll
            for (int m = 0; m < 4; ++m)
#pragma unroll
                for (int n = 0; n < 2; ++n) acc[a][b][m][n] = (f32x4){0.f, 0.f, 0.f, 0.f};
    bf16x8 At[4][2], B0[2][2], B1[2][2];
    const char* cA = (const char*)g.A + (size_t)cur.pm * tA + (g.agrp ? (size_t)(cur.pn >> 1) * 1024 : 0);
    const char* cB = (const char*)g.Bt + (size_t)cur.pn * tB;
    PG8_STAGE(PG8_SB(0, 0), cB, voffB); PG8_STAGE(PG8_SB(0, 1), cB + hB, voffB); PG8_STAGE(PG8_SA(0, 0), cA, voffA); PG8_STAGE(PG8_SA(0, 1), cA + hA, voffA);
    if (wr == 1) PG8_BAR;
    PG8_WAIT_V(2); PG8_BAR;
    PG8_STAGE(PG8_SB(1, 0), cB + kstep, voffB); PG8_STAGE(PG8_SA(1, 0), cA + kstep, voffA); PG8_STAGE(PG8_SB(1, 1), cB + hB + kstep, voffB);
    PG8_WAIT_V(6); PG8_BAR;
    for (;;) {
        const bool has_next = S.next(ui + 1, nxt);
        const char* nA = has_next ? (const char*)g.A + (size_t)nxt.pm * tA + (g.agrp ? (size_t)(nxt.pn >> 1) * 1024 : 0) : cA;
        const char* nB = has_next ? (const char*)g.Bt + (size_t)nxt.pn * tB : cB;
        for (int t = 0; t < nt; t += 2) {
            const bool last = (t == nt - 2);
            const char* a1 = cA + (size_t)(t + 1) * kstep;
            const char* a2 = last ? nA : cA + (size_t)(t + 2) * kstep; const char* b2 = last ? nB : cB + (size_t)(t + 2) * kstep;
            const char* a3 = a2 + kstep; const char* b3 = b2 + kstep;
            PG8_LDB(B0, 0, 0); PG8_LDB(B1, 0, 1); PG8_SCHED; PG8_LDA(At, 0, 0); PG8_STAGE(PG8_SA(1, 1), a1 + hA, voffA);
            PG8_WAIT_V(8); PG8_WAIT_L(0); PG8_BAR; PG8_MMA(0, 0, At, B0); PG8_MMA(0, 1, At, B1); PG8_BAR; PG8_SCHED;
            PG8_LDA(At, 0, 1); PG8_STAGE(PG8_SB(0, 0), b2, voffB); PG8_STAGE(PG8_SB(0, 1), b2 + hB, voffB); PG8_STAGE(PG8_SA(0, 0), a2, voffA);
            PG8_WAIT_V(8); PG8_WAIT_L(0); PG8_BAR; PG8_MMA(1, 0, At, B0); PG8_MMA(1, 1, At, B1); PG8_BAR; PG8_SCHED;
            PG8_LDB(B0, 1, 0); PG8_LDB(B1, 1, 1); PG8_SCHED; PG8_LDA(At, 1, 0); PG8_STAGE(PG8_SA(0, 1), a2 + hA, voffA);
            PG8_WAIT_V(8); PG8_WAIT_L(0); PG8_BAR; PG8_MMA(0, 0, At, B0); PG8_MMA(0, 1, At, B1); PG8_BAR; PG8_SCHED;
            PG8_LDA(At, 1, 1); PG8_STAGE(PG8_SB(1, 0), b3, voffB); PG8_STAGE(PG8_SB(1, 1), b3 + hB, voffB); PG8_STAGE(PG8_SA(1, 0), a3, voffA);
            PG8_WAIT_V(8); PG8_WAIT_L(0); PG8_BAR; PG8_MMA(1, 0, At, B0); PG8_MMA(1, 1, At, B1); PG8_BAR; PG8_SCHED;
        }
        if (wr == 0) PG8_BAR;
        E(acc, cur, wr, wc, fr, fq);
        if (!has_next) break;
#pragma unroll
        for (int a = 0; a < 2; ++a)
#pragma unroll
            for (int b = 0; b < 2; ++b)
#pragma unroll
                for (int m = 0; m < 4; ++m)
#pragma unroll
                    for (int n = 0; n < 2; ++n) acc[a][b][m][n] = (f32x4){0.f, 0.f, 0.f, 0.f};
        cur = nxt; cA = nA; cB = nB; ++ui;
        if (wr == 1) PG8_BAR;
    }
    PG8_WAIT_V(0);
    PG8_BAR;
#undef PG8_SA
#undef PG8_SB
#undef PG8_STAGE
#undef PG8_LDA
#undef PG8_LDB
#undef PG8_MMA
#undef PG8_WAIT_V
#undef PG8_WAIT_L
#undef PG8_BAR
#undef PG8_SCHED
}
}

constexpr int NT_CONV = 2 * 256 + 8 * 16 + 2 * 256 + 512 + 256 + 1152 + 128 + 4 * 1024 + 4 * 1024;
__device__ __forceinline__ void wjob(const Params& p, int tile, const float*& src, bf16_t*& dst, const float*& gain, int& K, int& N, int& lt) {
    bf16_t* W = (bf16_t*)(p.ws + OFF_W);
    int r = tile;
#define WJ(SRC, DOFF, KK, NN, CNT, GAIN, GSTR) { constexpr int tp = ((KK) / 64) * ((NN) / 256); if (r < tp * (CNT)) { const int inst = r / tp; lt = r - inst * tp; \
        src = (SRC) + (size_t)inst * (KK) * (NN); dst = W + (DOFF) + (size_t)inst * (KK) * (NN); gain = (GAIN) ? (GAIN) + inst * (GSTR) : nullptr; K = (KK); N = (NN); return; } r -= tp * (CNT); }
    WJ(p.mlp_w_up, WUP, 2048, 8192, 4, p.norm_mlp, DM)
    WJ(p.mlp_w_down, WDN, 8192, 2048, 4, (const float*)nullptr, 0)
    WJ(p.attn_w_qkv, WQKV, 2048, 9216, 1, p.norm_mix + 2 * DM, 0)
    WJ(p.pool_w_in, WPI, 2048, 2048, 2, p.norm_mix, 3 * DM)
    WJ(p.pool_w_out, WPO, 2048, 2048, 2, (const float*)nullptr, 0)
    WJ(p.sgu_w_in, WSI, 2048, 4096, 1, p.norm_mix + DM, 0)
    WJ(p.sgu_w_out, WSO, 2048, 2048, 1, (const float*)nullptr, 0)
    WJ(p.attn_w_out, WAO, 1024, 2048, 1, (const float*)nullptr, 0)
    WJ(p.pool_w_group, WPG, 512, 512, 8, (const float*)nullptr, 0)
#undef WJ
    src = p.pool_w_group; dst = W + WPG; gain = nullptr; K = 512; N = 512; lt = 0;
}
__device__ __forceinline__ void convert_phase(const Params& p, LAS unsigned char* lds) {
    LAS float* tl = (LAS float*)lds;
    const int tid = tid_fresh(), G = gdim_fresh(), bid = bid_fresh();
    const int kr = tid >> 6, c4 = tid & 63;
    f32x4 rg[8];
    int tile = bid;
    const float* src = nullptr; bf16_t* dst = nullptr; const float* gain = nullptr; int K = 0, N = 0, lt = 0, k0 = 0, n0 = 0;
    bool have = tile < NT_CONV;
    if (have) {
        wjob(p, tile, src, dst, gain, K, N, lt);
        const int nn = N >> 8; k0 = (lt / nn) * 64; n0 = (lt % nn) * 256;
#pragma unroll
        for (int i = 0; i < 8; ++i) rg[i] = *(const f32x4*)(src + (size_t)(k0 + kr + 8 * i) * N + n0 + c4 * 4);
    }
    while (have) {
#pragma unroll
        for (int i = 0; i < 8; ++i) { LAS float* q = tl + (kr + 8 * i) * 257 + c4 * 4; q[0] = rg[i][0]; q[1] = rg[i][1]; q[2] = rg[i][2]; q[3] = rg[i][3]; }
        __syncthreads();
        bf16_t* cdst = dst; const float* cgain = gain; const int cK = K, ck0 = k0, cn0 = n0;
        tile += G; have = tile < NT_CONV;
        if (have) {
            wjob(p, tile, src, dst, gain, K, N, lt);
            const int nn = N >> 8; k0 = (lt / nn) * 64; n0 = (lt % nn) * 256;
#pragma unroll
            for (int i = 0; i < 8; ++i) rg[i] = *(const f32x4*)(src + (size_t)(k0 + kr + 8 * i) * N + n0 + c4 * 4);
        }
        const int kq = tid & 7;
        f32x4 g0 = (f32x4){1.f, 1.f, 1.f, 1.f}, g1 = g0;
        if (cgain) { g0 = *(const f32x4*)(cgain + ck0 + kq * 8); g1 = *(const f32x4*)(cgain + ck0 + kq * 8 + 4); }
#pragma unroll
        for (int pass = 0; pass < 4; ++pass) {
            const int n = (tid >> 3) + 64 * pass;
            const LAS float* q = tl + (kq * 8) * 257 + n;
            u32x4 w; w.x = cvt_pk_bf16(q[0] * g0[0], q[257] * g0[1]); w.y = cvt_pk_bf16(q[2 * 257] * g0[2], q[3 * 257] * g0[3]);
            w.z = cvt_pk_bf16(q[4 * 257] * g1[0], q[5 * 257] * g1[1]); w.w = cvt_pk_bf16(q[6 * 257] * g1[2], q[7 * 257] * g1[3]);
            *(u32x4*)(cdst + (size_t)(cn0 + n) * cK + ck0 + kq * 8) = w;
        }
        __syncthreads();
    }
    {
        const int wid = tid >> 6, lane = tid & 63;
        bf16_t* xb = (bf16_t*)(p.ws + OFF_H); float* ss0 = (float*)(p.ws + OFF_SS);
        for (int row = bid * 8 + wid; row < SEQ; row += G * 8) {
            const float* xr = p.x + (size_t)row * DM + lane * 8;
            f32x4 v[8];
#pragma unroll
            for (int i = 0; i < 4; ++i) { v[2 * i] = *(const f32x4*)(xr + 512 * i); v[2 * i + 1] = *(const f32x4*)(xr + 512 * i + 4); }
            float sq = 0.f;
#pragma unroll
            for (int i = 0; i < 8; ++i) sq += (v[i][0] * v[i][0] + v[i][1] * v[i][1]) + (v[i][2] * v[i][2] + v[i][3] * v[i][3]);
#pragma unroll
            for (int o = 1; o < 64; o <<= 1) sq += __shfl_xor(sq, o);
#pragma unroll
            for (int i = 0; i < 4; ++i) {
                u32x4 w; w.x = cvt_pk_bf16(v[2 * i][0], v[2 * i][1]); w.y = cvt_pk_bf16(v[2 * i][2], v[2 * i][3]); w.z = cvt_pk_bf16(v[2 * i + 1][0], v[2 * i + 1][1]); w.w = cvt_pk_bf16(v[2 * i + 1][2], v[2 * i + 1][3]);
                *(u32x4*)(xb + (size_t)row * DM + lane * 8 + 512 * i) = w;
            }
            if (lane < 32) ss0[(size_t)row * 32 + lane] = (lane == 0) ? sq : 0.f;
        }
    }
}

template <bool FINAL>
__device__ __forceinline__ void norm_phase(const float* src, const float* gain, bf16_t* dst, float* fdst) {
    const int tid = tid_fresh(), wid = tid >> 6, lane = tid & 63;
    const int NW = gdim_fresh() * 8;
    for (int row = bid_fresh() * 8 + wid; row < SEQ; row += NW) {
        const float* xr = src + (size_t)row * DM + lane * 8;
        f32x4 v[8];
#pragma unroll
        for (int i = 0; i < 4; ++i) { v[2 * i] = *(const f32x4*)(xr + 512 * i); v[2 * i + 1] = *(const f32x4*)(xr + 512 * i + 4); }
        float ss = 0.f;
#pragma unroll
        for (int i = 0; i < 8; ++i) ss += (v[i][0] * v[i][0] + v[i][1] * v[i][1]) + (v[i][2] * v[i][2] + v[i][3] * v[i][3]);
#pragma unroll
        for (int o = 1; o < 64; o <<= 1) ss += __shfl_xor(ss, o);
        const float rstd = 1.0f / sqrtf(ss * (1.0f / DM) + RMS_EPS);
#pragma unroll
        for (int i = 0; i < 4; ++i) {
            const f32x4 g0 = *(const f32x4*)(gain + lane * 8 + 512 * i), g1 = *(const f32x4*)(gain + lane * 8 + 512 * i + 4);
            const f32x4 y0 = v[2 * i] * rstd * g0, y1 = v[2 * i + 1] * rstd * g1;
            if (FINAL) { float* o = fdst + (size_t)row * DM + lane * 8 + 512 * i; *(f32x4*)o = y0; *(f32x4*)(o + 4) = y1; }
            else { u32x4 w; w.x = cvt_pk_bf16(y0[0], y0[1]); w.y = cvt_pk_bf16(y0[2], y0[3]); w.z = cvt_pk_bf16(y1[0], y1[1]); w.w = cvt_pk_bf16(y1[2], y1[3]);
                *(u32x4*)(dst + (size_t)row * DM + lane * 8 + 512 * i) = w; }
        }
    }
}

__device__ __forceinline__ void pool_phase(const bf16_t* a, bf16_t* o) {
    const int G = gdim_fresh();
    for (int item = bid_fresh() * 512 + tid_fresh(); item < (SEQ / 32) * 256; item += G * 512) {
        const int cc = item & 255, run = item >> 8, c = cc * 8, w = 2 << (c >> 9), t0 = run * 32;
        float s[8];
#pragma unroll
        for (int e = 0; e < 8; ++e) s[e] = 0.f;
        for (int k = 1; k <= w; ++k) {
            if (t0 - k >= 0) {
                const u32x4 q = *(const u32x4*)(a + (size_t)(t0 - k) * DM + c);
                s[0] += bf_lo(q.x); s[1] += bf_hi(q.x); s[2] += bf_lo(q.y); s[3] += bf_hi(q.y); s[4] += bf_lo(q.z); s[5] += bf_hi(q.z); s[6] += bf_lo(q.w); s[7] += bf_hi(q.w);
            }
        }
        for (int t = t0; t < t0 + 32; ++t) {
            const u32x4 q = *(const u32x4*)(a + (size_t)t * DM + c);
            float cu[8] = {bf_lo(q.x), bf_hi(q.x), bf_lo(q.y), bf_hi(q.y), bf_lo(q.z), bf_hi(q.z), bf_lo(q.w), bf_hi(q.w)};
#pragma unroll
            for (int e = 0; e < 8; ++e) s[e] += cu[e];
            if (t - w >= 0) {
                const u32x4 r = *(const u32x4*)(a + (size_t)(t - w) * DM + c);
                s[0] -= bf_lo(r.x); s[1] -= bf_hi(r.x); s[2] -= bf_lo(r.y); s[3] -= bf_hi(r.y); s[4] -= bf_lo(r.z); s[5] -= bf_hi(r.z); s[6] -= bf_lo(r.w); s[7] -= bf_hi(r.w);
            }
            const float cnt = (float)((t + 1 < w) ? (t + 1) : w);
            u32x4 wv;
            wv.x = cvt_pk_bf16(s[0] / cnt - cu[0], s[1] / cnt - cu[1]); wv.y = cvt_pk_bf16(s[2] / cnt - cu[2], s[3] / cnt - cu[3]);
            wv.z = cvt_pk_bf16(s[4] / cnt - cu[4], s[5] / cnt - cu[5]); wv.w = cvt_pk_bf16(s[6] / cnt - cu[6], s[7] / cnt - cu[7]);
            *(u32x4*)(o + (size_t)t * DM + c) = wv;
        }
    }
}

__device__ __forceinline__ unsigned hw(const u32x4& v, int ci) { const unsigned w = (ci >> 1) == 0 ? v.x : (ci >> 1) == 1 ? v.y : (ci >> 1) == 2 ? v.z : v.w; return (ci & 1) ? (w >> 16) : (w & 0xffffu); }
__device__ __forceinline__ u32x4 tr_col(const u32x4 (&in)[8], int ci) {
    u32x4 o; o.x = hw(in[0], ci) | (hw(in[1], ci) << 16); o.y = hw(in[2], ci) | (hw(in[3], ci) << 16); o.z = hw(in[4], ci) | (hw(in[5], ci) << 16); o.w = hw(in[6], ci) | (hw(in[7], ci) << 16); return o;
}

__device__ __forceinline__ void sgu_phase(const Params& p, LAS unsigned char* lds) {
    const bf16_t* hh = (const bf16_t*)(p.ws + OFF_T1);
    bf16_t* gated = (bf16_t*)(p.ws + OFF_T2);
    const float* vss = (const float*)(p.ws + OFF_VSS);
    LAS bf16_t* WsL = (LAS bf16_t*)lds;
    LAS bf16_t* VtL = (LAS bf16_t*)(lds + 34816);
    LAS float* rsL = (LAS float*)(lds + 34816 + 69632);
    const int tid = tid_fresh(), wid = tid >> 6, lane = tid & 63, fr = lane & 15, fq = lane >> 4, G = gdim_fresh();
    for (int unit = bid_fresh(); unit < 1024; unit += G) {
        const int n = unit >> 3, g = unit & 7, t0 = n * 128, cg0 = g * 256;
        if (tid < 128) {
            const float* vp = vss + (size_t)(t0 + tid) * 32; float t = 0.f;
#pragma unroll
            for (int i = 0; i < 8; ++i) { const f32x4 q = *(const f32x4*)(vp + 4 * i); t += (q[0] + q[1]) + (q[2] + q[3]); }
            rsL[tid] = 1.0f / sqrtf(t * (1.0f / 2048.0f) + RMS_EPS);
        }
        const int sb = tid >> 5, cb = tid & 31;
        u32x4 vin[8];
#pragma unroll
        for (int i = 0; i < 8; ++i) vin[i] = *(const u32x4*)(hh + (size_t)(t0 + sb * 8 + i) * 4096 + 2048 + cg0 + cb * 8);
        __syncthreads();
        {
            const int t = tid >> 2, s0 = (tid & 3) * 32;
            const float* wrow = p.sgu_w_s + (size_t)g * 16384 + t * 128 + s0;
#pragma unroll
            for (int i = 0; i < 8; ++i) {
                const f32x4 wv = *(const f32x4*)(wrow + 4 * i);
                float e[4];
#pragma unroll
                for (int q = 0; q < 4; ++q) { const int s = s0 + 4 * i + q; e[q] = (s <= t) ? wv[q] * rsL[s] : 0.f; }
                u32x2 pk; pk.x = cvt_pk_bf16(e[0], e[1]); pk.y = cvt_pk_bf16(e[2], e[3]);
                *(LAS u32x2*)(WsL + t * 136 + s0 + 4 * i) = pk;
            }
        }
#pragma unroll
        for (int ci = 0; ci < 8; ++ci) *(LAS u32x4*)(VtL + (cb * 8 + ci) * 136 + sb * 8) = tr_col(vin, ci);
        __syncthreads();
        bf16x8 Bf[2][4];
#pragma unroll
        for (int nb = 0; nb < 2; ++nb)
#pragma unroll
            for (int ks = 0; ks < 4; ++ks) Bf[nb][ks] = *(const LAS bf16x8*)(VtL + (wid * 32 + nb * 16 + fr) * 136 + ks * 32 + fq * 8);
        float vn[2];
#pragma unroll
        for (int nb = 0; nb < 2; ++nb) vn[nb] = p.sgu_v_norm[cg0 + wid * 32 + nb * 16 + fr];
#pragma unroll
        for (int mb = 0; mb < 8; ++mb) {
            f32x4 acc[2] = {(f32x4){0.f, 0.f, 0.f, 0.f}, (f32x4){0.f, 0.f, 0.f, 0.f}};
#pragma unroll
            for (int ks = 0; ks < 4; ++ks) {
                if (ks * 32 <= mb * 16 + 15) {
                    const bf16x8 Af = *(const LAS bf16x8*)(WsL + (mb * 16 + fr) * 136 + ks * 32 + fq * 8);
                    acc[0] = __builtin_amdgcn_mfma_f32_16x16x32_bf16(Af, Bf[0][ks], acc[0], 0, 0, 0);
                    acc[1] = __builtin_amdgcn_mfma_f32_16x16x32_bf16(Af, Bf[1][ks], acc[1], 0, 0, 0);
                }
            }
#pragma unroll
            for (int j = 0; j < 4; ++j) {
                const int t = mb * 16 + fq * 4 + j;
                const float bs = p.sgu_b_s[g * 128 + t];
#pragma unroll
                for (int nb = 0; nb < 2; ++nb) {
                    const int c = cg0 + wid * 32 + nb * 16 + fr;
                    const float sp = acc[nb][j] * vn[nb] + bs;
                    const float u = bf2f(hh[(size_t)(t0 + t) * 4096 + c]);
                    gated[(size_t)(t0 + t) * 2048 + c] = f2bf(u * sp);
                }
            }
        }
        __syncthreads();
    }
}

__device__ __forceinline__ void attn_phase(const Params& p, LAS unsigned char* lds) {
    const bf16_t* qkv = (const bf16_t*)(p.ws + OFF_T1);
    bf16_t* og = (bf16_t*)(p.ws + OFF_T2);
    float* lse = (float*)(p.ws + OFF_LSE);
    LAS bf16_t* KL = (LAS bf16_t*)lds;
    LAS bf16_t* VtL = (LAS bf16_t*)lds;
    const int tid = tid_fresh(), wid = tid >> 6, lane = tid & 63, fr = lane & 15, fq = lane >> 4, G = gdim_fresh();
    LAS bf16_t* PLw = (LAS bf16_t*)(lds + 69632) + wid * (16 * 264);
    const float scale = 0.08838834764831845f;
    for (int unit = bid_fresh(); unit < 3072; unit += G) {
        const int g = unit >> 10, rem = unit & 1023, h = rem >> 7, rb = rem & 127;
        const int dsh = 2 * g, d = 1 << dsh, r = rb & (d - 1), blk = rb >> dsh, i0 = blk * 128;
        const int col_q = g * 1024 + h * 128, col_k = 3072 + col_q, col_v = 6144 + col_q;
        bf16x8 Qf[4];
        { const size_t tq = (size_t)(r + d * (i0 + wid * 16 + fr));
#pragma unroll
          for (int ks = 0; ks < 4; ++ks) Qf[ks] = *(const bf16x8*)(qkv + tq * 9216 + col_q + ks * 32 + fq * 8); }
#pragma unroll
        for (int i = 0; i < 8; ++i) {
            const int cid = tid + 512 * i, key = cid >> 4, dc = cid & 15, kk = i0 - 128 + key;
            u32x4 v = (u32x4){0u, 0u, 0u, 0u};
            if (kk >= 0) v = *(const u32x4*)(qkv + (size_t)(r + d * kk) * 9216 + col_k + dc * 8);
            *(LAS u32x4*)(KL + key * 136 + dc * 8) = v;
        }
        const int keyb = tid >> 4, db = tid & 15;
        u32x4 vin[8];
#pragma unroll
        for (int i = 0; i < 8; ++i) {
            const int kk = i0 - 128 + keyb * 8 + i;
            vin[i] = (u32x4){0u, 0u, 0u, 0u};
            if (kk >= 0) vin[i] = *(const u32x4*)(qkv + (size_t)(r + d * kk) * 9216 + col_v + db * 8);
        }
        __syncthreads();
        f32x4 sa[16];
#pragma unroll
        for (int kb = 0; kb < 16; ++kb) {
            sa[kb] = (f32x4){0.f, 0.f, 0.f, 0.f};
#pragma unroll
            for (int ks = 0; ks < 4; ++ks) {
                const bf16x8 Kf = *(const LAS bf16x8*)(KL + (kb * 16 + fr) * 136 + ks * 32 + fq * 8);
                sa[kb] = __builtin_amdgcn_mfma_f32_16x16x32_bf16(Qf[ks], Kf, sa[kb], 0, 0, 0);
            }
        }
        float mx[4] = {-3.0e38f, -3.0e38f, -3.0e38f, -3.0e38f};
#pragma unroll
        for (int kb = 0; kb < 16; ++kb)
#pragma unroll
            for (int j = 0; j < 4; ++j) {
                const int diff = (wid * 16 + fq * 4 + j) + 128 - kb * 16 - fr;
                const int kk = i0 - 128 + kb * 16 + fr;
                const bool valid = (kk >= 0) && (diff >= 0) && (diff <= 128);
                const float s = valid ? sa[kb][j] * scale : -1.0e30f;
                sa[kb][j] = s; mx[j] = fmaxf(mx[j], s);
            }
#pragma unroll
        for (int j = 0; j < 4; ++j) {
#pragma unroll
            for (int o = 1; o < 16; o <<= 1) mx[j] = fmaxf(mx[j], __shfl_xor(mx[j], o));
        }
        float ls[4] = {0.f, 0.f, 0.f, 0.f};
#pragma unroll
        for (int kb = 0; kb < 16; ++kb)
#pragma unroll
            for (int j = 0; j < 4; ++j) {
                const float pv = __expf(sa[kb][j] - mx[j]);
                ls[j] += pv;
                PLw[(fq * 4 + j) * 264 + kb * 16 + fr] = f2bf(pv);
            }
#pragma unroll
        for (int j = 0; j < 4; ++j) {
#pragma unroll
            for (int o = 1; o < 16; o <<= 1) ls[j] += __shfl_xor(ls[j], o);
        }
        __syncthreads();
#pragma unroll
        for (int di = 0; di < 8; ++di) *(LAS u32x4*)(VtL + (db * 8 + di) * 264 + keyb * 8) = tr_col(vin, di);
        __syncthreads();
        f32x4 oa[8];
#pragma unroll
        for (int nb = 0; nb < 8; ++nb) oa[nb] = (f32x4){0.f, 0.f, 0.f, 0.f};
#pragma unroll
        for (int ks = 0; ks < 8; ++ks) {
            const bf16x8 Pf = *(const LAS bf16x8*)(PLw + fr * 264 + ks * 32 + fq * 8);
#pragma unroll
            for (int nb = 0; nb < 8; ++nb) {
                const bf16x8 Vf = *(const LAS bf16x8*)(VtL + (nb * 16 + fr) * 264 + ks * 32 + fq * 8);
                oa[nb] = __builtin_amdgcn_mfma_f32_16x16x32_bf16(Pf, Vf, oa[nb], 0, 0, 0);
            }
        }
#pragma unroll
        for (int j = 0; j < 4; ++j) {
            const size_t tok = (size_t)(r + d * (i0 + wid * 16 + fq * 4 + j));
            const float inv = 1.0f / ls[j];
            bf16_t* orow = og + ((size_t)g * SEQ + tok) * 1024 + h * 128 + fr;
#pragma unroll
            for (int nb = 0; nb < 8; ++nb) orow[nb * 16] = f2bf(oa[nb][j] * inv);
            if (fr == 0) lse[((size_t)g * SEQ + tok) * 8 + h] = mx[j] + logf(ls[j]);
        }
        __syncthreads();
    }
}

__device__ __forceinline__ void merge_phase(const Params& p) {
    const bf16_t* og = (const bf16_t*)(p.ws + OFF_T2);
    const float* lse = (const float*)(p.ws + OFF_LSE);
    bf16_t* o = (bf16_t*)(p.ws + OFF_T1);
    const int G = gdim_fresh();
    for (int item = bid_fresh() * 512 + tid_fresh(); item < SEQ * 128; item += G * 512) {
        const int t = item >> 7, c8 = item & 127, h = c8 >> 4;
        const float l0 = lse[((size_t)0 * SEQ + t) * 8 + h], l1 = lse[((size_t)1 * SEQ + t) * 8 + h], l2 = lse[((size_t)2 * SEQ + t) * 8 + h];
        const float m = fmaxf(l0, fmaxf(l1, l2));
        float w0 = __expf(l0 - m), w1 = __expf(l1 - m), w2 = __expf(l2 - m);
        const float inv = 1.0f / (w0 + w1 + w2); w0 *= inv; w1 *= inv; w2 *= inv;
        const u32x4 a = *(const u32x4*)(og + ((size_t)0 * SEQ + t) * 1024 + c8 * 8), b = *(const u32x4*)(og + ((size_t)1 * SEQ + t) * 1024 + c8 * 8), c = *(const u32x4*)(og + ((size_t)2 * SEQ + t) * 1024 + c8 * 8);
        u32x4 w;
        w.x = cvt_pk_bf16(w0 * bf_lo(a.x) + w1 * bf_lo(b.x) + w2 * bf_lo(c.x), w0 * bf_hi(a.x) + w1 * bf_hi(b.x) + w2 * bf_hi(c.x));
        w.y = cvt_pk_bf16(w0 * bf_lo(a.y) + w1 * bf_lo(b.y) + w2 * bf_lo(c.y), w0 * bf_hi(a.y) + w1 * bf_hi(b.y) + w2 * bf_hi(c.y));
        w.z = cvt_pk_bf16(w0 * bf_lo(a.z) + w1 * bf_lo(b.z) + w2 * bf_lo(c.z), w0 * bf_hi(a.z) + w1 * bf_hi(b.z) + w2 * bf_hi(c.z));
        w.w = cvt_pk_bf16(w0 * bf_lo(a.w) + w1 * bf_lo(b.w) + w2 * bf_lo(c.w), w0 * bf_hi(a.w) + w1 * bf_hi(b.w) + w2 * bf_hi(c.w));
        *(u32x4*)(o + (size_t)t * 1024 + c8 * 8) = w;
    }
}


#define XB_TMO      128
#define XB_XCNT(j)  (256  + 64 * (j))
#define XB_XSUB(j)  (1280 + 64 * (j))
#define XB_XGEN(j)  (2304 + 64 * (j))
#define XB_TOP      3328
#define XB_TOPGEN   3392
#define XCD_BAR_WORDS 3456
#define XB_SPIN_CAP (1u << 22)
__device__ __forceinline__ unsigned xb_ld(unsigned* p)              { return __hip_atomic_load(p, __ATOMIC_RELAXED, __HIP_MEMORY_SCOPE_AGENT); }
__device__ __forceinline__ unsigned xb_add(unsigned* p, unsigned v) { return __hip_atomic_fetch_add(p, v, __ATOMIC_RELAXED, __HIP_MEMORY_SCOPE_AGENT); }
__device__ __forceinline__ unsigned xb_xcc_id() { return (unsigned)__builtin_amdgcn_s_getreg((3 << 11) | 20) & 0xFu; }
#define XB_SPIN(cond, bar) do { unsigned _sp = 0; while (cond) { __builtin_amdgcn_s_sleep(1); \
    if ((++_sp & 255u) == 0u) { if (xb_ld(&(bar)[XB_TMO])) break; if (_sp > XB_SPIN_CAP) { atomicAdd(&(bar)[XB_TMO], 1u); break; } } } } while (0)
__device__ __forceinline__ void xcd_barrier_complete(unsigned* bar, unsigned x, unsigned& nloc, unsigned& nx) {
    const unsigned G = gridDim.x;
    unsigned sum, cnt, mine, sp = 0u;
    for (;;) {
        sum = 0u; cnt = 0u; mine = 0u;
#pragma unroll
        for (unsigned j = 0; j < 16; ++j) { const unsigned c = xb_ld(&bar[XB_XCNT(j)]); sum += c; cnt += (c > 0u) ? 1u : 0u; mine = (j == x) ? c : mine; }
        if (sum == G) break;
        __builtin_amdgcn_s_sleep(1);
        if ((++sp & 255u) == 0u) { if (xb_ld(&bar[XB_TMO])) break; if (sp > XB_SPIN_CAP) { atomicAdd(&bar[XB_TMO], 1u); break; } }
    }
    nloc = mine > 0u ? mine : 1u; nx = cnt > 0u ? cnt : 1u;
}
__device__ __forceinline__ void xcd_barrier(unsigned* bar, volatile LAS unsigned* st) {
    asm volatile("s_waitcnt vmcnt(0)" ::: "memory");
    __syncthreads();
    if (threadIdx.x == 0) {
        const unsigned x = xb_xcc_id();
        __builtin_amdgcn_s_waitcnt(0);
        unsigned nloc = st[0], nx = st[1];
        if (nloc == 0u) { xcd_barrier_complete(bar, x, nloc, nx); st[0] = nloc; st[1] = nx; }
        const unsigned old = xb_add(&bar[XB_XSUB(x)], 1u);
        const unsigned gen = old / nloc;
        if (old + 1u == (gen + 1u) * nloc) {
            __builtin_amdgcn_fence(__ATOMIC_RELEASE, "agent");
            asm volatile("s_waitcnt vmcnt(0)" ::: "memory");
            const unsigned og = xb_add(&bar[XB_TOP], 1u);
            const unsigned tg = og / nx;
            if (og + 1u == (tg + 1u) * nx) xb_add(&bar[XB_TOPGEN], 1u);
            else XB_SPIN(xb_ld(&bar[XB_TOPGEN]) == tg, bar);
            __builtin_amdgcn_fence(__ATOMIC_ACQUIRE, "agent");
            xb_add(&bar[XB_XGEN(x)], 1u);
            asm volatile("s_waitcnt vmcnt(0)" ::: "memory");
        } else {
            XB_SPIN(xb_ld(&bar[XB_XGEN(x)]) == gen, bar);
            __builtin_amdgcn_fence(__ATOMIC_ACQUIRE, "agent");
            asm volatile("s_waitcnt vmcnt(0)" ::: "memory");
        }
    }
    __syncthreads();
}

enum { ST_NORM = 0, ST_GEMM_BF16 = 1, ST_GEMM_RESID = 2, ST_POOL = 3, ST_SGU = 4, ST_ATTN = 5, ST_MERGE = 6 };

__device__ __forceinline__ Params kparams() {
#if defined(__HIP_DEVICE_COMPILE__)
    typedef const __attribute__((address_space(4))) Params* KP;
    KP pp = (KP)__builtin_amdgcn_kernarg_segment_ptr();
    asm volatile("" : "+s"(pp));
    Params r;
    r.x = pp->x; r.norm_mix = pp->norm_mix; r.pool_w_in = pp->pool_w_in; r.pool_w_group = pp->pool_w_group; r.pool_scale = pp->pool_scale; r.pool_w_out = pp->pool_w_out;
    r.sgu_w_in = pp->sgu_w_in; r.sgu_v_norm = pp->sgu_v_norm; r.sgu_w_s = pp->sgu_w_s; r.sgu_b_s = pp->sgu_b_s; r.sgu_w_out = pp->sgu_w_out;
    r.attn_w_qkv = pp->attn_w_qkv; r.attn_w_out = pp->attn_w_out; r.norm_mlp = pp->norm_mlp; r.mlp_w_up = pp->mlp_w_up; r.mlp_w_down = pp->mlp_w_down; r.norm_final = pp->norm_final;
    r.out = pp->out; r.ws = pp->ws;
    return r;
#else
    return Params{};
#endif
}

__global__ void __launch_bounds__(512, 2) fwd_kernel(Params p_unused) {
    extern __shared__ __attribute__((aligned(16))) unsigned char smem[];
    LAS unsigned char* lds = (LAS unsigned char*)smem;
    cg::grid_group grid = cg::this_grid();

    volatile LAS unsigned* bst = (volatile LAS unsigned*)(lds + LDS_BYTES - 16);
    { const Params p0 = kparams();
      unsigned* bar0 = (unsigned*)(p0.ws + OFF_BAR);
      if (blockIdx.x == 0) for (int i = threadIdx.x; i < XCD_BAR_WORDS; i += 512) bar0[i] = 0u;
      if (threadIdx.x == 0) { bst[0] = 0u; bst[1] = 0u; }
      convert_phase(p0, lds); }
    grid.sync();
    { unsigned* bar0 = (unsigned*)(kparams().ws + OFF_BAR); if (threadIdx.x == 0) (void)xb_add(&bar0[XB_XCNT(xb_xcc_id())], 1u); }

    for (int layer = 0; layer < 4; ++layer) {
        const int kind = layer % 3, j = layer / 3;
        const int nsteps = (kind == 1) ? 5 : 6;
        for (int s = 0; s < nsteps; ++s) {
            const Params p = kparams();
            const int mlp0 = nsteps - 2;
            int st;
            if (s == mlp0) st = ST_GEMM_BF16;
            else if (s == mlp0 + 1 || s == mlp0 - 1) st = ST_GEMM_RESID;
            else if (s == 0) st = ST_GEMM_BF16;
            else if (kind == 0) st = (s == 1) ? ST_POOL : ST_GEMM_BF16;
            else if (kind == 1) st = ST_SGU;
            else st = (s == 1) ? ST_ATTN : ST_MERGE;
            float* const SS = (float*)(p.ws + OFF_SS);
            if (st == ST_GEMM_BF16) {
                bf16_t* const W = (bf16_t*)(p.ws + OFF_W);
                pg8::Gemm g; g.M = SEQ; g.A = (const bf16_t*)(p.ws + OFF_H); g.lda = 2048; g.K = 2048; g.agrp = 0;
                pg8::EpiBf16 E; E.O = (bf16_t*)(p.ws + OFF_T1); E.colscale = p.pool_scale; E.vss = (float*)(p.ws + OFF_VSS); E.ss = SS + (size_t)(2 * layer) * SEQ * 32;
                if (s == mlp0) { g.Bt = W + WUP + (size_t)layer * 8192 * 2048; g.N = 8192; E.act = pg8::ACT_RELU2; E.ss = SS + (size_t)(2 * layer + 1) * SEQ * 32; }
                else if (kind == 0 && s == 0) { g.Bt = W + WPI + (size_t)j * 2048 * 2048; g.N = 2048; E.act = pg8::ACT_NONE; }
                else if (kind == 0) { g.A = (const bf16_t*)(p.ws + OFF_T2); g.K = 512; g.agrp = 1; g.Bt = W + WPG + (size_t)j * 2048 * 512; g.N = 2048; E.act = pg8::ACT_COLSCALE; E.colscale = p.pool_scale + j * DM; E.ss = nullptr; }
                else if (kind == 1) { g.Bt = W + WSI; g.N = 4096; E.act = pg8::ACT_GELU_VSS; }
                else { g.Bt = W + WQKV; g.N = 9216; E.act = pg8::ACT_NONE; }
                E.ldc = g.N;
                pg8::StaticOrder so; so.init(SEQ, g.N, gdim_fresh(), bid_fresh());
                pg8::gemm_phase<pg8::EpiBf16>(lds, g, so, E);
            } else if (st == ST_GEMM_RESID) {
                bf16_t* const W = (bf16_t*)(p.ws + OFF_W);
                pg8::Gemm g; g.M = SEQ; g.N = 2048; g.agrp = 0;
                pg8::EpiResid E; E.xin = p.out; E.out = p.out; E.ldc = DM; E.xb = (bf16_t*)(p.ws + OFF_H);
                if (s == mlp0 + 1) { g.A = (const bf16_t*)(p.ws + OFF_T1); g.lda = 8192; g.K = 8192; g.Bt = W + WDN + (size_t)layer * 8192 * 2048; E.ss = (layer < 3) ? SS + (size_t)(2 * layer + 2) * SEQ * 32 : nullptr; }
                else {
                    E.ss = SS + (size_t)(2 * layer + 1) * SEQ * 32;
                    if (kind == 0) { g.A = (const bf16_t*)(p.ws + OFF_T1); g.lda = 2048; g.K = 2048; g.Bt = W + WPO + (size_t)j * 2048 * 2048; if (layer == 0) E.xin = p.x; }
                    else if (kind == 1) { g.A = (const bf16_t*)(p.ws + OFF_T2); g.lda = 2048; g.K = 2048; g.Bt = W + WSO; }
                    else { g.A = (const bf16_t*)(p.ws + OFF_T1); g.lda = 1024; g.K = 1024; g.Bt = W + WAO; }
                }
                pg8::StaticOrder so; so.init(SEQ, g.N, gdim_fresh(), bid_fresh());
                pg8::gemm_phase<pg8::EpiResid>(lds, g, so, E);
            } else if (st == ST_POOL) {
                pool_phase((const bf16_t*)(p.ws + OFF_T1), (bf16_t*)(p.ws + OFF_T2));
            } else if (st == ST_SGU) {
                sgu_phase(p, lds);
            } else if (st == ST_ATTN) {
                attn_phase(p, lds);
            } else {
                merge_phase(p);
            }
            xcd_barrier((unsigned*)(kparams().ws + OFF_BAR), bst);
        }
    }
    { const Params p = kparams(); norm_phase<true>(p.out, p.norm_final, nullptr, p.out); }
}

extern "C" void kernel_launch(void* const* d_in, const int* in_sizes, int n_in, void* d_out, int out_size, void* d_ws, size_t ws_size, hipStream_t stream) {
    static int grid = 0;
    if (grid == 0) {
        if (n_in != 17 || out_size != SEQ * DM || ws_size < WS_END) { fprintf(stderr, "kernel_launch: unexpected shapes (n_in %d, out %d, ws %zu, need %zu)\n", n_in, out_size, ws_size, (size_t)WS_END); grid = -1; return; }
        int dev = 0, cus = 0, per_cu = 0;
        hipGetDevice(&dev);
        hipDeviceGetAttribute(&cus, hipDeviceAttributeMultiprocessorCount, dev);
        if (hipFuncSetAttribute((const void*)fwd_kernel, hipFuncAttributeMaxDynamicSharedMemorySize, (int)LDS_BYTES) != hipSuccess) { fprintf(stderr, "kernel_launch: hipFuncSetAttribute failed\n"); grid = -1; return; }
        if (hipOccupancyMaxActiveBlocksPerMultiprocessor(&per_cu, (const void*)fwd_kernel, 512, LDS_BYTES) != hipSuccess || per_cu < 1) { fprintf(stderr, "kernel_launch: occupancy query gave %d\n", per_cu); per_cu = 1; }
        (void)hipGetLastError();
        grid = cus * per_cu;
    }
    if (grid < 0) return;
    Params p{};
    p.x = (const float*)d_in[0]; p.norm_mix = (const float*)d_in[1]; p.pool_w_in = (const float*)d_in[2]; p.pool_w_group = (const float*)d_in[3];
    p.pool_scale = (const float*)d_in[4]; p.pool_w_out = (const float*)d_in[5]; p.sgu_w_in = (const float*)d_in[6]; p.sgu_v_norm = (const float*)d_in[7];
    p.sgu_w_s = (const float*)d_in[8]; p.sgu_b_s = (const float*)d_in[9]; p.sgu_w_out = (const float*)d_in[10]; p.attn_w_qkv = (const float*)d_in[11];
    p.attn_w_out = (const float*)d_in[12]; p.norm_mlp = (const float*)d_in[13]; p.mlp_w_up = (const float*)d_in[14]; p.mlp_w_down = (const float*)d_in[15];
    p.norm_final = (const float*)d_in[16];
    p.out = (float*)d_out; p.ws = (unsigned char*)d_ws;
    void* args[] = {&p};
    hipError_t e = hipLaunchCooperativeKernel((const void*)fwd_kernel, dim3(grid), dim3(512), args, LDS_BYTES, stream);
    if (e != hipSuccess) fprintf(stderr, "kernel_launch: cooperative launch failed: %s (grid %d)\n", hipGetErrorString(e), grid);
}
```

```cpp
#include <hip/hip_runtime.h>
#include <hip/hip_cooperative_groups.h>
#include <cstdio>
#include <cstdint>
namespace cg = cooperative_groups;

#define LAS __attribute__((address_space(3)))
typedef unsigned short bf16_t;
typedef short bf16x8 __attribute__((ext_vector_type(8)));
typedef float f32x4 __attribute__((ext_vector_type(4)));
typedef float f32x2 __attribute__((ext_vector_type(2)));
typedef unsigned u32x4 __attribute__((ext_vector_type(4)));
typedef unsigned u32x2 __attribute__((ext_vector_type(2)));

constexpr int SEQ = 16384, DM = 2048, DFF = 8192;
constexpr float RMS_EPS = 1e-6f;

constexpr size_t OFF_BAR = 0;
constexpr size_t OFF_VSS = 16384;
constexpr size_t OFF_SS = OFF_VSS + (size_t)SEQ * 32 * 4;
constexpr size_t OFF_LSE = OFF_SS + (size_t)8 * SEQ * 32 * 4;
constexpr size_t OFF_W = OFF_LSE + (size_t)3 * SEQ * 8 * 4;
constexpr size_t WPI = 0;
constexpr size_t WPG = WPI + (size_t)2 * 2048 * 2048;
constexpr size_t WPO = WPG + (size_t)2 * 2048 * 512;
constexpr size_t WSI = WPO + (size_t)2 * 2048 * 2048;
constexpr size_t WSO = WSI + (size_t)4096 * 2048;
constexpr size_t WQKV = WSO + (size_t)2048 * 2048;
constexpr size_t WAO = WQKV + (size_t)9216 * 2048;
constexpr size_t WUP = WAO + (size_t)2048 * 1024;
constexpr size_t WDN = WUP + (size_t)4 * 8192 * 2048;
constexpr size_t WEND = WDN + (size_t)4 * 8192 * 2048;
constexpr size_t OFF_H = OFF_W + WEND * 2;
constexpr size_t OFF_T1 = OFF_H + (size_t)SEQ * 2048 * 2;
constexpr size_t OFF_T2 = OFF_T1 + (size_t)SEQ * 9216 * 2;
constexpr size_t WS_END = OFF_T2 + (size_t)3 * SEQ * 1024 * 2;
constexpr size_t LDS_BYTES = 143360;

struct Params {
    const float *x, *norm_mix, *pool_w_in, *pool_w_group, *pool_scale, *pool_w_out, *sgu_w_in, *sgu_v_norm, *sgu_w_s, *sgu_b_s, *sgu_w_out,
        *attn_w_qkv, *attn_w_out, *norm_mlp, *mlp_w_up, *mlp_w_down, *norm_final;
    float* out;
    unsigned char* ws;
};

__device__ __forceinline__ unsigned cvt_pk_bf16(float lo, float hi) { unsigned r; asm volatile("v_cvt_pk_bf16_f32 %0, %1, %2" : "=v"(r) : "v"(lo), "v"(hi)); return r; }
__device__ __forceinline__ float bf_lo(unsigned w) { return __uint_as_float(w << 16); }
__device__ __forceinline__ float bf_hi(unsigned w) { return __uint_as_float(w & 0xffff0000u); }
__device__ __forceinline__ float bf2f(bf16_t b) { return __uint_as_float(((unsigned)b) << 16); }
__device__ __forceinline__ bf16_t f2bf(float f) { return (bf16_t)(cvt_pk_bf16(f, 0.f) & 0xffffu); }

__device__ __forceinline__ int tid_fresh() { int t = threadIdx.x; asm volatile("" : "+v"(t)); return t; }
__device__ __forceinline__ int bid_fresh() { int b = blockIdx.x; asm volatile("" : "+s"(b)); return b; }
__device__ __forceinline__ int gdim_fresh() { int g = gridDim.x; asm volatile("" : "+s"(g)); return g; }

__device__ __forceinline__ f32x2 gelu_pk(f32x2 v) {
    const f32x2 av = __builtin_elementwise_abs(v), d = av * 0.2316418882f + 1.0f;
    f32x2 t; t.x = __builtin_amdgcn_rcpf(d.x); t.y = __builtin_amdgcn_rcpf(d.y);
    f32x2 q = t * 0.5307027145f + (-0.7265760135f); q = q * t + 0.7107068705f; q = q * t + (-0.142248368f); q = q * t + 0.127414796f; q = q * t;
    const f32x2 s = (v * v) * (-0.72134752044f);
    f32x2 e; e.x = __builtin_amdgcn_exp2f(s.x); e.y = __builtin_amdgcn_exp2f(s.y);
    const f32x2 m = v * (q * e), r = v - m;
    f32x2 o; o.x = v.x < 0.f ? m.x : r.x; o.y = v.y < 0.f ? m.y : r.y; return o;
}

namespace pg8 {
constexpr int BM = 256, BK = 64, HALF = 128, HTB = HALF * BK * 2, STAGE_BYTES = 8 * HTB, NXCD = 8, WGM = 8;
__device__ __forceinline__ int lds_byte(int r, int c) { const int st = (r >> 4) * 2 + (c >> 5), rr = r & 15, cc = c & 31, ob = rr * 64 + cc * 2; return st * 1024 + (ob ^ (((ob >> 9) & 1) << 5)); }
__device__ __forceinline__ void stage_rc(int b, int& R, int& C) { const int st = b / 1024, sb = b % 1024, swz = sb ^ (((sb >> 9) & 1) << 5); R = (st >> 1) * 16 + swz / 64; C = (st & 1) * 32 + (swz % 64) / 2; }
__device__ __forceinline__ int perm32(int rho) { const int n = rho >> 4, i = rho & 15; return 8 * (i >> 2) + 4 * n + (i & 3); }

struct Unit { int pm, pn; };
struct Gemm { const bf16_t* A; const bf16_t* Bt; int M, N, K, lda, agrp; };

struct StaticOrder {
    int nM, nN, nwg, G, c;
    __device__ void init(int M, int N, int G_, int c_) { nM = M / BM; nN = N / BM; nwg = nM * nN; G = G_; c = c_; }
    __device__ bool next(int i, Unit& u) const {
        const long L = (long)i * G + c; if (L >= nwg) return false;
        int wgid = (int)L; { const int q = nwg / NXCD, r = nwg % NXCD, xcd = wgid % NXCD, off = wgid / NXCD; wgid = (xcd < r ? xcd * (q + 1) : r * (q + 1) + (xcd - r) * q) + off; }
        const int wgm = (nN == 8) ? 4 : WGM;
        const int nig = wgm * nN, gid = wgid / nig, fm = gid * wgm, gsz = (nM - fm) < wgm ? (nM - fm) : wgm;
        u.pm = fm + ((wgid % nig) % gsz); u.pn = (wgid % nig) / gsz; return true;
    }
};

enum { ACT_NONE = 0, ACT_GELU_VSS = 1, ACT_RELU2 = 2, ACT_COLSCALE = 3 };
struct EpiBf16 {
    static constexpr bool PERM = true;
    bf16_t* O; int ldc; int act; const float* colscale; float* vss; const float* ss;
    __device__ __forceinline__ void operator()(const f32x4 (&acc)[2][2][4][2], const Unit& u, int wr, int wc, int fr, int fq) const {
        const int row0 = u.pm * BM + wr * 64 + fr, col0 = u.pn * BM + wc * 32 + 8 * fq;
        const bool do_vss = (act == ACT_GELU_VSS) && (u.pn * BM >= 2048);
        float rsv[8];
#pragma unroll
        for (int gi = 0; gi < 8; ++gi) rsv[gi] = 1.0f;
        if (this->ss) {
#pragma unroll
            for (int hb = 0; hb < 2; ++hb) {
                f32x4 p0[4], p1[4];
#pragma unroll
                for (int m = 0; m < 4; ++m) { const float* pp = this->ss + (size_t)(row0 + hb * HALF + m * 16) * 32 + fq * 8; p0[m] = *(const f32x4*)pp; p1[m] = *(const f32x4*)(pp + 4); }
#pragma unroll
                for (int m = 0; m < 4; ++m) {
                    float t = ((p0[m][0] + p0[m][1]) + (p0[m][2] + p0[m][3])) + ((p1[m][0] + p1[m][1]) + (p1[m][2] + p1[m][3]));
                    t += __shfl_xor(t, 16); t += __shfl_xor(t, 32);
                    rsv[hb * 4 + m] = 1.0f / sqrtf(t * (1.0f / DM) + RMS_EPS);
                }
            }
        }
#pragma unroll
        for (int ai = 0; ai < 2; ++ai)
#pragma unroll
            for (int m = 0; m < 4; ++m) {
                const int row = row0 + ai * HALF + m * 16;
                bf16_t* rowp = O + (size_t)row * ldc + col0;
                float ss = 0.f;
                const float rs = rsv[ai * 4 + m];
#pragma unroll
                for (int bj = 0; bj < 2; ++bj) {
                    f32x4 v0 = acc[ai][bj][m][0] * rs, v1 = acc[ai][bj][m][1] * rs;
                    if (act == ACT_GELU_VSS) {
                        f32x2 a = gelu_pk((f32x2){v0[0], v0[1]}), b = gelu_pk((f32x2){v0[2], v0[3]}), c = gelu_pk((f32x2){v1[0], v1[1]}), d = gelu_pk((f32x2){v1[2], v1[3]});
                        v0 = (f32x4){a.x, a.y, b.x, b.y}; v1 = (f32x4){c.x, c.y, d.x, d.y};
                        ss += (v0[0] * v0[0] + v0[1] * v0[1]) + (v0[2] * v0[2] + v0[3] * v0[3]) + (v1[0] * v1[0] + v1[1] * v1[1]) + (v1[2] * v1[2] + v1[3] * v1[3]);
                    } else if (act == ACT_RELU2) {
#pragma unroll
                        for (int j = 0; j < 4; ++j) { const float a = fmaxf(v0[j], 0.f), b = fmaxf(v1[j], 0.f); v0[j] = a * a; v1[j] = b * b; }
                    } else if (act == ACT_COLSCALE) {
                        v0 = v0 * *(const f32x4*)(colscale + col0 + bj * HALF); v1 = v1 * *(const f32x4*)(colscale + col0 + bj * HALF + 4);
                    }
                    u32x4 w; w.x = cvt_pk_bf16(v0[0], v0[1]); w.y = cvt_pk_bf16(v0[2], v0[3]); w.z = cvt_pk_bf16(v1[0], v1[1]); w.w = cvt_pk_bf16(v1[2], v1[3]);
                    *(u32x4*)(rowp + bj * HALF) = w;
                }
                if (do_vss) { ss += __shfl_xor(ss, 16); ss += __shfl_xor(ss, 32); if (fq == 0) vss[(size_t)row * 32 + (u.pn - 8) * 4 + wc] = ss; }
            }
    }
};
struct EpiResid {
    static constexpr bool PERM = false;
    const float* xin; float* out; int ldc; bf16_t* xb; float* ss;
    __device__ __forceinline__ void operator()(const f32x4 (&acc)[2][2][4][2], const Unit& u, int wr, int wc, int fr, int fq) const {
        const int row0 = u.pm * BM + wr * 64 + fr, col0 = u.pn * BM + wc * 32 + 4 * fq;
        f32x4 bs[2][4];
#pragma unroll
        for (int q = 0; q < 4; ++q) bs[0][q] = *(const f32x4*)(xin + (size_t)row0 * ldc + col0 + (q >> 1) * HALF + (q & 1) * 16);
#pragma unroll
        for (int gi = 0; gi < 8; ++gi) {
            const int ai = gi >> 2, m = gi & 3;
            const int row = row0 + ai * HALF + m * 16;
            const size_t off = (size_t)row * ldc + col0;
            if (gi + 1 < 8) {
                const size_t offn = (size_t)(row0 + ((gi + 1) >> 2) * HALF + ((gi + 1) & 3) * 16) * ldc + col0;
#pragma unroll
                for (int q = 0; q < 4; ++q) bs[(gi + 1) & 1][q] = *(const f32x4*)(xin + offn + (q >> 1) * HALF + (q & 1) * 16);
            }
            float sq = 0.f;
#pragma unroll
            for (int q = 0; q < 4; ++q) {
                const int bj = q >> 1, n = q & 1;
                const f32x4 o = bs[gi & 1][q] + acc[ai][bj][m][n];
                *(f32x4*)(out + off + bj * HALF + n * 16) = o;
                if (ss) {
                    u32x2 w; w.x = cvt_pk_bf16(o[0], o[1]); w.y = cvt_pk_bf16(o[2], o[3]);
                    *(u32x2*)(xb + off + bj * HALF + n * 16) = w;
                    sq += (o[0] * o[0] + o[1] * o[1]) + (o[2] * o[2] + o[3] * o[3]);
                }
            }
            if (ss) { sq += __shfl_xor(sq, 16); sq += __shfl_xor(sq, 32); if (fq == 0) ss[(size_t)row * 32 + u.pn * 4 + wc] = sq; }
        }
    }
};

template <class Epi>
__device__ __forceinline__ void gemm_phase(LAS unsigned char* lds, const Gemm g, const StaticOrder& S, const Epi& E) {
    const int tid = tid_fresh(), wid = __builtin_amdgcn_readfirstlane(tid >> 6), lane = tid & 63, wr = wid >> 2, wc = wid & 3, fr = lane & 15, fq = lane >> 4;
    const int K = g.K, nt = K / BK, lda = g.lda;
    unsigned voffA[2], voffB[2];
#pragma unroll
    for (int i = 0; i < 2; ++i) { int R, C; stage_rc(tid * 16 + i * 8192, R, C); const int Rb = Epi::PERM ? ((R & ~31) + perm32(R & 31)) : R;
        voffA[i] = (unsigned)(R * lda + C) * 2u; voffB[i] = (unsigned)(Rb * K + C) * 2u; }
    const size_t kstep = (size_t)(BK * 2);
    const size_t hA = (size_t)HALF * lda * 2, hB = (size_t)HALF * K * 2;
    const size_t tA = 2 * hA, tB = 2 * hB;
    const unsigned ldsw = (unsigned)wid * 1024u;
    const int aoff = lds_byte(wr * 64 + fr, fq * 8), boff = lds_byte(wc * 32 + fr, fq * 8);
#define PG8_SA(b, h) (((b) * 2 + (h)) * HTB)
#define PG8_SB(b, h) ((4 + (b) * 2 + (h)) * HTB)
#define PG8_STAGE(bufoff, gbase, voff) do { _Pragma("unroll") for (int _i = 0; _i < 2; ++_i) \
        __builtin_amdgcn_global_load_lds((const unsigned*)((const char*)(gbase) + (voff)[_i]), (LAS unsigned*)(lds + (bufoff) + ldsw + _i * 8192), 16, 0, 0); } while (0)
#define PG8_LDA(dst, b, h) do { _Pragma("unroll") for (int m = 0; m < 4; ++m) _Pragma("unroll") for (int k = 0; k < 2; ++k) dst[m][k] = *(const LAS bf16x8*)(lds + PG8_SA(b, h) + aoff + m * 2048 + k * 1024); } while (0)
#define PG8_LDB(dst, b, h) do { _Pragma("unroll") for (int n = 0; n < 2; ++n) _Pragma("unroll") for (int k = 0; k < 2; ++k) dst[n][k] = *(const LAS bf16x8*)(lds + PG8_SB(b, h) + boff + n * 2048 + k * 1024); } while (0)
#define PG8_MMA(ai, bj, At, Bt) do { __builtin_amdgcn_s_setprio(1); _Pragma("unroll") for (int m = 0; m < 4; ++m) _Pragma("unroll") for (int n = 0; n < 2; ++n) _Pragma("unroll") for (int k = 0; k < 2; ++k) \
        acc[ai][bj][m][n] = __builtin_amdgcn_mfma_f32_16x16x32_bf16(Bt[n][k], At[m][k], acc[ai][bj][m][n], 0, 0, 0); __builtin_amdgcn_s_setprio(0); } while (0)
#define PG8_WAIT_V(n) asm volatile("s_waitcnt vmcnt(" #n ")" ::: "memory")
#define PG8_WAIT_L(n) asm volatile("s_waitcnt lgkmcnt(" #n ")" ::: "memory")
#define PG8_BAR __builtin_amdgcn_s_barrier()
#define PG8_SCHED __builtin_amdgcn_sched_barrier(0)
    Unit cur, nxt; int ui = 0;
    if (!S.next(0, cur)) return;
    f32x4 acc[2][2][4][2];
#pragma unroll
    for (int a = 0; a < 2; ++a)
#pragma unroll
        for (int b = 0; b < 2; ++b)
#pragma unroll
            for (int m = 0; m < 4; ++m)
#pragma unroll
                for (int n = 0; n < 2; ++n) acc[a][b][m][n] = (f32x4){0.f, 0.f, 0.f, 0.f};
    bf16x8 At[4][2], B0[2][2], B1[2][2];
    const char* cA = (const char*)g.A + (size_t)cur.pm * tA + (g.agrp ? (size_t)(cur.pn >> 1) * 1024 : 0);
    const char* cB = (const char*)g.Bt + (size_t)cur.pn * tB;
    PG8_STAGE(PG8_SB(0, 0), cB, voffB); PG8_STAGE(PG8_SB(0, 1), cB + hB, voffB); PG8_STAGE(PG8_SA(0, 0), cA, voffA); PG8_STAGE(PG8_SA(0, 1), cA + hA, voffA);
    if (wr == 1) PG8_BAR;
    PG8_WAIT_V(2); PG8_BAR;
    PG8_STAGE(PG8_SB(1, 0), cB + kstep, voffB); PG8_STAGE(PG8_SA(1, 0), cA + kstep, voffA); PG8_STAGE(PG8_SB(1, 1), cB + hB + kstep, voffB);
    PG8_WAIT_V(6); PG8_BAR;
    for (;;) {
        const bool has_next = S.next(ui + 1, nxt);
        const char* nA = has_next ? (const char*)g.A + (size_t)nxt.pm * tA + (g.agrp ? (size_t)(nxt.pn >> 1) * 1024 : 0) : cA;
        const char* nB = has_next ? (const char*)g.Bt + (size_t)nxt.pn * tB : cB;
        for (int t = 0; t < nt; t += 2) {
            const bool last = (t == nt - 2);
            const char* a1 = cA + (size_t)(t + 1) * kstep;
            const char* a2 = last ? nA : cA + (size_t)(t + 2) * kstep; const char* b2 = last ? nB : cB + (size_t)(t + 2) * kstep;
            const char* a3 = a2 + kstep; const char* b3 = b2 + kstep;
            PG8_LDB(B0, 0, 0); PG8_LDB(B1, 0, 1); PG8_SCHED; PG8_LDA(At, 0, 0); PG8_STAGE(PG8_SA(1, 1), a1 + hA, voffA);
            PG8_WAIT_V(8); PG8_WAIT_L(0); PG8_BAR; PG8_MMA(0, 0, At, B0); PG8_MMA(0, 1, At, B1); PG8_BAR; PG8_SCHED;
            PG8_LDA(At, 0, 1); PG8_STAGE(PG8_SB(0, 0), b2, voffB); PG8_STAGE(PG8_SB(0, 1), b2 + hB, voffB); PG8_STAGE(PG8_SA(0, 0), a2, voffA);
            PG8_WAIT_V(8); PG8_WAIT_L(0); PG8_BAR; PG8_MMA(1, 0, At, B0); PG8_MMA(1, 1, At, B1); PG8_BAR; PG8_SCHED;
            PG8_LDB(B0, 1, 0); PG8_LDB(B1, 1, 1); PG8_SCHED; PG8_LDA(At, 1, 0); PG8_STAGE(PG8_SA(0, 1), a2 + hA, voffA);
            PG8_WAIT_V(8); PG8_WAIT_L(0); PG8_BAR; PG8_MMA(0, 0, At, B0); PG8_MMA(0, 1, At, B1); PG8_BAR; PG8_SCHED;
            PG8_LDA(At, 1, 1); PG8_STAGE(PG8_SB(1, 0), b3, voffB); PG8_STAGE(PG8_SB(1, 1), b3 + hB, voffB); PG8_STAGE(PG8_SA(1, 0), a3, voffA);
            PG8_WAIT_V(8); PG8_WAIT_L(0); PG8_BAR; PG8_MMA(1, 0, At, B0); PG8_MMA(1, 1, At, B1); PG8_BAR; PG8_SCHED;
        }
        if (wr == 0) PG8_BAR;
        E(acc, cur, wr, wc, fr, fq);
        if (!has_next) break;
#pragma unroll
        for (int a = 0; a < 2; ++a)
#pragma unroll
            for (int b = 0; b < 2; ++b)
#pragma unroll
                for (int m = 0; m < 4; ++m)
#pragma unroll
                    for (int n = 0; n < 2; ++n) acc[a][b][m][n] = (f32x4){0.f, 0.f, 0.f, 0.f};
        cur = nxt; cA = nA; cB = nB; ++ui;
        if (wr == 1) PG8_BAR;
    }
    PG8_WAIT_V(0);
    PG8_BAR;
#undef PG8_SA
#undef PG8_SB
#undef PG8_STAGE
#undef PG8_LDA
#undef PG8_LDB
#undef PG8_MMA
#undef PG8_WAIT_V
#undef PG8_WAIT_L
#undef PG8_BAR
#undef PG8_SCHED
}
}

constexpr int NT_CONV = 2 * 256 + 8 * 16 + 2 * 256 + 512 + 256 + 1152 + 128 + 4 * 1024 + 4 * 1024;
__device__ __forceinline__ void wjob(const Params& p, int tile, const float*& src, bf16_t*& dst, const float*& gain, int& K, int& N, int& lt) {
    bf16_t* W = (bf16_t*)(p.ws + OFF_W);
    int r = tile;
#define WJ(SRC, DOFF, KK, NN, CNT, GAIN, GSTR) { constexpr int tp = ((KK) / 64) * ((NN) / 256); if (r < tp * (CNT)) { const int inst = r / tp; lt = r - inst * tp; \
        src = (SRC) + (size_t)inst * (KK) * (NN); dst = W + (DOFF) + (size_t)inst * (KK) * (NN); gain = (GAIN) ? (GAIN) + inst * (GSTR) : nullptr; K = (KK); N = (NN); return; } r -= tp * (CNT); }
    WJ(p.mlp_w_up, WUP, 2048, 8192, 4, p.norm_mlp, DM)
    WJ(p.mlp_w_down, WDN, 8192, 2048, 4, (const float*)nullptr, 0)
    WJ(p.attn_w_qkv, WQKV, 2048, 9216, 1, p.norm_mix + 2 * DM, 0)
    WJ(p.pool_w_in, WPI, 2048, 2048, 2, p.norm_mix, 3 * DM)
    WJ(p.pool_w_out, WPO, 2048, 2048, 2, (const float*)nullptr, 0)
    WJ(p.sgu_w_in, WSI, 2048, 4096, 1, p.norm_mix + DM, 0)
    WJ(p.sgu_w_out, WSO, 2048, 2048, 1, (const float*)nullptr, 0)
    WJ(p.attn_w_out, WAO, 1024, 2048, 1, (const float*)nullptr, 0)
    WJ(p.pool_w_group, WPG, 512, 512, 8, (const float*)nullptr, 0)
#undef WJ
    src = p.pool_w_group; dst = W + WPG; gain = nullptr; K = 512; N = 512; lt = 0;
}
__device__ __forceinline__ void convert_phase(const Params& p, LAS unsigned char* lds) {
    LAS float* tl = (LAS float*)lds;
    const int tid = tid_fresh(), G = gdim_fresh(), bid = bid_fresh();
    const int kr = tid >> 6, c4 = tid & 63;
    f32x4 rg[8];
    int tile = bid;
    const float* src = nullptr; bf16_t* dst = nullptr; const float* gain = nullptr; int K = 0, N = 0, lt = 0, k0 = 0, n0 = 0;
    bool have = tile < NT_CONV;
    if (have) {
        wjob(p, tile, src, dst, gain, K, N, lt);
        const int nn = N >> 8; k0 = (lt / nn) * 64; n0 = (lt % nn) * 256;
#pragma unroll
        for (int i = 0; i < 8; ++i) rg[i] = *(const f32x4*)(src + (size_t)(k0 + kr + 8 * i) * N + n0 + c4 * 4);
    }
    while (have) {
#pragma unroll
        for (int i = 0; i < 8; ++i) { LAS float* q = tl + (kr + 8 * i) * 257 + c4 * 4; q[0] = rg[i][0]; q[1] = rg[i][1]; q[2] = rg[i][2]; q[3] = rg[i][3]; }
        __syncthreads();
        bf16_t* cdst = dst; const float* cgain = gain; const int cK = K, ck0 = k0, cn0 = n0;
        tile += G; have = tile < NT_CONV;
        if (have) {
            wjob(p, tile, src, dst, gain, K, N, lt);
            const int nn = N >> 8; k0 = (lt / nn) * 64; n0 = (lt % nn) * 256;
#pragma unroll
            for (int i = 0; i < 8; ++i) rg[i] = *(const f32x4*)(src + (size_t)(k0 + kr + 8 * i) * N + n0 + c4 * 4);
        }
        const int kq = tid & 7;
        f32x4 g0 = (f32x4){1.f, 1.f, 1.f, 1.f}, g1 = g0;
        if (cgain) { g0 = *(const f32x4*)(cgain + ck0 + kq * 8); g1 = *(const f32x4*)(cgain + ck0 + kq * 8 + 4); }
#pragma unroll
        for (int pass = 0; pass < 4; ++pass) {
            const int n = (tid >> 3) + 64 * pass;
            const LAS float* q = tl + (kq * 8) * 257 + n;
            u32x4 w; w.x = cvt_pk_bf16(q[0] * g0[0], q[257] * g0[1]); w.y = cvt_pk_bf16(q[2 * 257] * g0[2], q[3 * 257] * g0[3]);
            w.z = cvt_pk_bf16(q[4 * 257] * g1[0], q[5 * 257] * g1[1]); w.w = cvt_pk_bf16(q[6 * 257] * g1[2], q[7 * 257] * g1[3]);
            *(u32x4*)(cdst + (size_t)(cn0 + n) * cK + ck0 + kq * 8) = w;
        }
        __syncthreads();
    }
    {
        const int wid = tid >> 6, lane = tid & 63;
        bf16_t* xb = (bf16_t*)(p.ws + OFF_H); float* ss0 = (float*)(p.ws + OFF_SS);
        for (int row = bid * 8 + wid; row < SEQ; row += G * 8) {
            const float* xr = p.x + (size_t)row * DM + lane * 8;
            f32x4 v[8];
#pragma unroll
            for (int i = 0; i < 4; ++i) { v[2 * i] = *(const f32x4*)(xr + 512 * i); v[2 * i + 1] = *(const f32x4*)(xr + 512 * i + 4); }
            float sq = 0.f;
#pragma unroll
            for (int i = 0; i < 8; ++i) sq += (v[i][0] * v[i][0] + v[i][1] * v[i][1]) + (v[i][2] * v[i][2] + v[i][3] * v[i][3]);
#pragma unroll
            for (int o = 1; o < 64; o <<= 1) sq += __shfl_xor(sq, o);
#pragma unroll
            for (int i = 0; i < 4; ++i) {
                u32x4 w; w.x = cvt_pk_bf16(v[2 * i][0], v[2 * i][1]); w.y = cvt_pk_bf16(v[2 * i][2], v[2 * i][3]); w.z = cvt_pk_bf16(v[2 * i + 1][0], v[2 * i + 1][1]); w.w = cvt_pk_bf16(v[2 * i + 1][2], v[2 * i + 1][3]);
                *(u32x4*)(xb + (size_t)row * DM + lane * 8 + 512 * i) = w;
            }
            if (lane < 32) ss0[(size_t)row * 32 + lane] = (lane == 0) ? sq : 0.f;
        }
    }
}

template <bool FINAL>
__device__ __forceinline__ void norm_phase(const float* src, const float* gain, bf16_t* dst, float* fdst) {
    const int tid = tid_fresh(), wid = tid >> 6, lane = tid & 63;
    const int NW = gdim_fresh() * 8;
    for (int row = bid_fresh() * 8 + wid; row < SEQ; row += NW) {
        const float* xr = src + (size_t)row * DM + lane * 8;
        f32x4 v[8];
#pragma unroll
        for (int i = 0; i < 4; ++i) { v[2 * i] = *(const f32x4*)(xr + 512 * i); v[2 * i + 1] = *(const f32x4*)(xr + 512 * i + 4); }
        float ss = 0.f;
#pragma unroll
        for (int i = 0; i < 8; ++i) ss += (v[i][0] * v[i][0] + v[i][1] * v[i][1]) + (v[i][2] * v[i][2] + v[i][3] * v[i][3]);
#pragma unroll
        for (int o = 1; o < 64; o <<= 1) ss += __shfl_xor(ss, o);
        const float rstd = 1.0f / sqrtf(ss * (1.0f / DM) + RMS_EPS);
#pragma unroll
        for (int i = 0; i < 4; ++i) {
            const f32x4 g0 = *(const f32x4*)(gain + lane * 8 + 512 * i), g1 = *(const f32x4*)(gain + lane * 8 + 512 * i + 4);
            const f32x4 y0 = v[2 * i] * rstd * g0, y1 = v[2 * i + 1] * rstd * g1;
            if (FINAL) { float* o = fdst + (size_t)row * DM + lane * 8 + 512 * i; *(f32x4*)o = y0; *(f32x4*)(o + 4) = y1; }
            else { u32x4 w; w.x = cvt_pk_bf16(y0[0], y0[1]); w.y = cvt_pk_bf16(y0[2], y0[3]); w.z = cvt_pk_bf16(y1[0], y1[1]); w.w = cvt_pk_bf16(y1[2], y1[3]);
                *(u32x4*)(dst + (size_t)row * DM + lane * 8 + 512 * i) = w; }
        }
    }
}

__device__ __forceinline__ void pool_phase(const bf16_t* a, bf16_t* o) {
    const int G = gdim_fresh();
    for (int item = bid_fresh() * 512 + tid_fresh(); item < (SEQ / 32) * 256; item += G * 512) {
        const int cc = item & 255, run = item >> 8, c = cc * 8, w = 2 << (c >> 9), t0 = run * 32;
        float s[8];
#pragma unroll
        for (int e = 0; e < 8; ++e) s[e] = 0.f;
        for (int k = 1; k <= w; ++k) {
            if (t0 - k >= 0) {
                const u32x4 q = *(const u32x4*)(a + (size_t)(t0 - k) * DM + c);
                s[0] += bf_lo(q.x); s[1] += bf_hi(q.x); s[2] += bf_lo(q.y); s[3] += bf_hi(q.y); s[4] += bf_lo(q.z); s[5] += bf_hi(q.z); s[6] += bf_lo(q.w); s[7] += bf_hi(q.w);
            }
        }
        for (int t = t0; t < t0 + 32; ++t) {
            const u32x4 q = *(const u32x4*)(a + (size_t)t * DM + c);
            float cu[8] = {bf_lo(q.x), bf_hi(q.x), bf_lo(q.y), bf_hi(q.y), bf_lo(q.z), bf_hi(q.z), bf_lo(q.w), bf_hi(q.w)};
#pragma unroll
            for (int e = 0; e < 8; ++e) s[e] += cu[e];
            if (t - w >= 0) {
                const u32x4 r = *(const u32x4*)(a + (size_t)(t - w) * DM + c);
                s[0] -= bf_lo(r.x); s[1] -= bf_hi(r.x); s[2] -= bf_lo(r.y); s[3] -= bf_hi(r.y); s[4] -= bf_lo(r.z); s[5] -= bf_hi(r.z); s[6] -= bf_lo(r.w); s[7] -= bf_hi(r.w);
            }
            const float cnt = (float)((t + 1 < w) ? (t + 1) : w);
            u32x4 wv;
            wv.x = cvt_pk_bf16(s[0] / cnt - cu[0], s[1] / cnt - cu[1]); wv.y = cvt_pk_bf16(s[2] / cnt - cu[2], s[3] / cnt - cu[3]);
            wv.z = cvt_pk_bf16(s[4] / cnt - cu[4], s[5] / cnt - cu[5]); wv.w = cvt_pk_bf16(s[6] / cnt - cu[6], s[7] / cnt - cu[7]);
            *(u32x4*)(o + (size_t)t * DM + c) = wv;
        }
    }
}

__device__ __forceinline__ unsigned hw(const u32x4& v, int ci) { const unsigned w = (ci >> 1) == 0 ? v.x : (ci >> 1) == 1 ? v.y : (ci >> 1) == 2 ? v.z : v.w; return (ci & 1) ? (w >> 16) : (w & 0xffffu); }
__device__ __forceinline__ u32x4 tr_col(const u32x4 (&in)[8], int ci) {
    u32x4 o; o.x = hw(in[0], ci) | (hw(in[1], ci) << 16); o.y = hw(in[2], ci) | (hw(in[3], ci) << 16); o.z = hw(in[4], ci) | (hw(in[5], ci) << 16); o.w = hw(in[6], ci) | (hw(in[7], ci) << 16); return o;
}

__device__ __forceinline__ void sgu_phase(const Params& p, LAS unsigned char* lds) {
    const bf16_t* hh = (const bf16_t*)(p.ws + OFF_T1);
    bf16_t* gated = (bf16_t*)(p.ws + OFF_T2);
    const float* vss = (const float*)(p.ws + OFF_VSS);
    LAS bf16_t* WsL = (LAS bf16_t*)lds;
    LAS bf16_t* VtL = (LAS bf16_t*)(lds + 34816);
    LAS float* rsL = (LAS float*)(lds + 34816 + 69632);
    const int tid = tid_fresh(), wid = tid >> 6, lane = tid & 63, fr = lane & 15, fq = lane >> 4, G = gdim_fresh();
    for (int unit = bid_fresh(); unit < 1024; unit += G) {
        const int n = unit >> 3, g = unit & 7, t0 = n * 128, cg0 = g * 256;
        if (tid < 128) {
            const float* vp = vss + (size_t)(t0 + tid) * 32; float t = 0.f;
#pragma unroll
            for (int i = 0; i < 8; ++i) { const f32x4 q = *(const f32x4*)(vp + 4 * i); t += (q[0] + q[1]) + (q[2] + q[3]); }
            rsL[tid] = 1.0f / sqrtf(t * (1.0f / 2048.0f) + RMS_EPS);
        }
        const int sb = tid >> 5, cb = tid & 31;
        u32x4 vin[8];
#pragma unroll
        for (int i = 0; i < 8; ++i) vin[i] = *(const u32x4*)(hh + (size_t)(t0 + sb * 8 + i) * 4096 + 2048 + cg0 + cb * 8);
        __syncthreads();
        {
            const int t = tid >> 2, s0 = (tid & 3) * 32;
            const float* wrow = p.sgu_w_s + (size_t)g * 16384 + t * 128 + s0;
#pragma unroll
            for (int i = 0; i < 8; ++i) {
                const f32x4 wv = *(const f32x4*)(wrow + 4 * i);
                float e[4];
#pragma unroll
                for (int q = 0; q < 4; ++q) { const int s = s0 + 4 * i + q; e[q] = (s <= t) ? wv[q] * rsL[s] : 0.f; }
                u32x2 pk; pk.x = cvt_pk_bf16(e[0], e[1]); pk.y = cvt_pk_bf16(e[2], e[3]);
                *(LAS u32x2*)(WsL + t * 136 + s0 + 4 * i) = pk;
            }
        }
#pragma unroll
        for (int ci = 0; ci < 8; ++ci) *(LAS u32x4*)(VtL + (cb * 8 + ci) * 136 + sb * 8) = tr_col(vin, ci);
        __syncthreads();
        bf16x8 Bf[2][4];
#pragma unroll
        for (int nb = 0; nb < 2; ++nb)
#pragma unroll
            for (int ks = 0; ks < 4; ++ks) Bf[nb][ks] = *(const LAS bf16x8*)(VtL + (wid * 32 + nb * 16 + fr) * 136 + ks * 32 + fq * 8);
        float vn[2];
#pragma unroll
        for (int nb = 0; nb < 2; ++nb) vn[nb] = p.sgu_v_norm[cg0 + wid * 32 + nb * 16 + fr];
#pragma unroll
        for (int mb = 0; mb < 8; ++mb) {
            f32x4 acc[2] = {(f32x4){0.f, 0.f, 0.f, 0.f}, (f32x4){0.f, 0.f, 0.f, 0.f}};
#pragma unroll
            for (int ks = 0; ks < 4; ++ks) {
                if (ks * 32 <= mb * 16 + 15) {
                    const bf16x8 Af = *(const LAS bf16x8*)(WsL + (mb * 16 + fr) * 136 + ks * 32 + fq * 8);
                    acc[0] = __builtin_amdgcn_mfma_f32_16x16x32_bf16(Af, Bf[0][ks], acc[0], 0, 0, 0);
                    acc[1] = __builtin_amdgcn_mfma_f32_16x16x32_bf16(Af, Bf[1][ks], acc[1], 0, 0, 0);
                }
            }
#pragma unroll
            for (int j = 0; j < 4; ++j) {
                const int t = mb * 16 + fq * 4 + j;
                const float bs = p.sgu_b_s[g * 128 + t];
#pragma unroll
                for (int nb = 0; nb < 2; ++nb) {
                    const int c = cg0 + wid * 32 + nb * 16 + fr;
                    const float sp = acc[nb][j] * vn[nb] + bs;
                    const float u = bf2f(hh[(size_t)(t0 + t) * 4096 + c]);
                    gated[(size_t)(t0 + t) * 2048 + c] = f2bf(u * sp);
                }
            }
        }
        __syncthreads();
    }
}

__device__ __forceinline__ void attn_phase(const Params& p, LAS unsigned char* lds) {
    const bf16_t* qkv = (const bf16_t*)(p.ws + OFF_T1);
    bf16_t* og = (bf16_t*)(p.ws + OFF_T2);
    float* lse = (float*)(p.ws + OFF_LSE);
    LAS bf16_t* KL = (LAS bf16_t*)lds;
    LAS bf16_t* VtL = (LAS bf16_t*)lds;
    const int tid = tid_fresh(), wid = tid >> 6, lane = tid & 63, fr = lane & 15, fq = lane >> 4, G = gdim_fresh();
    LAS bf16_t* PLw = (LAS bf16_t*)(lds + 69632) + wid * (16 * 264);
    const float scale = 0.08838834764831845f;
    for (int unit = bid_fresh(); unit < 3072; unit += G) {
        const int g = unit >> 10, rem = unit & 1023, h = rem >> 7, rb = rem & 127;
        const int dsh = 2 * g, d = 1 << dsh, r = rb & (d - 1), blk = rb >> dsh, i0 = blk * 128;
        const int col_q = g * 1024 + h * 128, col_k = 3072 + col_q, col_v = 6144 + col_q;
        bf16x8 Qf[4];
        { const size_t tq = (size_t)(r + d * (i0 + wid * 16 + fr));
#pragma unroll
          for (int ks = 0; ks < 4; ++ks) Qf[ks] = *(const bf16x8*)(qkv + tq * 9216 + col_q + ks * 32 + fq * 8); }
#pragma unroll
        for (int i = 0; i < 8; ++i) {
            const int cid = tid + 512 * i, key = cid >> 4, dc = cid & 15, kk = i0 - 128 + key;
            u32x4 v = (u32x4){0u, 0u, 0u, 0u};
            if (kk >= 0) v = *(const u32x4*)(qkv + (size_t)(r + d * kk) * 9216 + col_k + dc * 8);
            *(LAS u32x4*)(KL + key * 136 + dc * 8) = v;
        }
        const int keyb = tid >> 4, db = tid & 15;
        u32x4 vin[8];
#pragma unroll
        for (int i = 0; i < 8; ++i) {
            const int kk = i0 - 128 + keyb * 8 + i;
            vin[i] = (u32x4){0u, 0u, 0u, 0u};
            if (kk >= 0) vin[i] = *(const u32x4*)(qkv + (size_t)(r + d * kk) * 9216 + col_v + db * 8);
        }
        __syncthreads();
        f32x4 sa[16];
#pragma unroll
        for (int kb = 0; kb < 16; ++kb) {
            sa[kb] = (f32x4){0.f, 0.f, 0.f, 0.f};
#pragma unroll
            for (int ks = 0; ks < 4; ++ks) {
                const bf16x8 Kf = *(const LAS bf16x8*)(KL + (kb * 16 + fr) * 136 + ks * 32 + fq * 8);
                sa[kb] = __builtin_amdgcn_mfma_f32_16x16x32_bf16(Qf[ks], Kf, sa[kb], 0, 0, 0);
            }
        }
        float mx[4] = {-3.0e38f, -3.0e38f, -3.0e38f, -3.0e38f};
#pragma unroll
        for (int kb = 0; kb < 16; ++kb)
#pragma unroll
            for (int j = 0; j < 4; ++j) {
                const int diff = (wid * 16 + fq * 4 + j) + 128 - kb * 16 - fr;
                const int kk = i0 - 128 + kb * 16 + fr;
                const bool valid = (kk >= 0) && (diff >= 0) && (diff <= 128);
                const float s = valid ? sa[kb][j] * scale : -1.0e30f;
                sa[kb][j] = s; mx[j] = fmaxf(mx[j], s);
            }
#pragma unroll
        for (int j = 0; j < 4; ++j) {
#pragma unroll
            for (int o = 1; o < 16; o <<= 1) mx[j] = fmaxf(mx[j], __shfl_xor(mx[j], o));
        }
        float ls[4] = {0.f, 0.f, 0.f, 0.f};
#pragma unroll
        for (int kb = 0; kb < 16; ++kb)
#pragma unroll
            for (int j = 0; j < 4; ++j) {
                const float pv = __expf(sa[kb][j] - mx[j]);
                ls[j] += pv;
                PLw[(fq * 4 + j) * 264 + kb * 16 + fr] = f2bf(pv);
            }
#pragma unroll
        for (int j = 0; j < 4; ++j) {
#pragma unroll
            for (int o = 1; o < 16; o <<= 1) ls[j] += __shfl_xor(ls[j], o);
        }
        __syncthreads();
#pragma unroll
        for (int di = 0; di < 8; ++di) *(LAS u32x4*)(VtL + (db * 8 + di) * 264 + keyb * 8) = tr_col(vin, di);
        __syncthreads();
        f32x4 oa[8];
#pragma unroll
        for (int nb = 0; nb < 8; ++nb) oa[nb] = (f32x4){0.f, 0.f, 0.f, 0.f};
#pragma unroll
        for (int ks = 0; ks < 8; ++ks) {
            const bf16x8 Pf = *(const LAS bf16x8*)(PLw + fr * 264 + ks * 32 + fq * 8);
#pragma unroll
            for (int nb = 0; nb < 8; ++nb) {
                const bf16x8 Vf = *(const LAS bf16x8*)(VtL + (nb * 16 + fr) * 264 + ks * 32 + fq * 8);
                oa[nb] = __builtin_amdgcn_mfma_f32_16x16x32_bf16(Pf, Vf, oa[nb], 0, 0, 0);
            }
        }
#pragma unroll
        for (int j = 0; j < 4; ++j) {
            const size_t tok = (size_t)(r + d * (i0 + wid * 16 + fq * 4 + j));
            const float inv = 1.0f / ls[j];
            bf16_t* orow = og + ((size_t)g * SEQ + tok) * 1024 + h * 128 + fr;
#pragma unroll
            for (int nb = 0; nb < 8; ++nb) orow[nb * 16] = f2bf(oa[nb][j] * inv);
            if (fr == 0) lse[((size_t)g * SEQ + tok) * 8 + h] = mx[j] + logf(ls[j]);
        }
        __syncthreads();
    }
}

__device__ __forceinline__ void merge_phase(const Params& p) {
    const bf16_t* og = (const bf16_t*)(p.ws + OFF_T2);
    const float* lse = (const float*)(p.ws + OFF_LSE);
    bf16_t* o = (bf16_t*)(p.ws + OFF_T1);
    const int G = gdim_fresh();
    for (int item = bid_fresh() * 512 + tid_fresh(); item < SEQ * 128; item += G * 512) {
        const int t = item >> 7, c8 = item & 127, h = c8 >> 4;
        const float l0 = lse[((size_t)0 * SEQ + t) * 8 + h], l1 = lse[((size_t)1 * SEQ + t) * 8 + h], l2 = lse[((size_t)2 * SEQ + t) * 8 + h];
        const float m = fmaxf(l0, fmaxf(l1, l2));
        float w0 = __expf(l0 - m), w1 = __expf(l1 - m), w2 = __expf(l2 - m);
        const float inv = 1.0f / (w0 + w1 + w2); w0 *= inv; w1 *= inv; w2 *= inv;
        const u32x4 a = *(const u32x4*)(og + ((size_t)0 * SEQ + t) * 1024 + c8 * 8), b = *(const u32x4*)(og + ((size_t)1 * SEQ + t) * 1024 + c8 * 8), c = *(const u32x4*)(og + ((size_t)2 * SEQ + t) * 1024 + c8 * 8);
        u32x4 w;
        w.x = cvt_pk_bf16(w0 * bf_lo(a.x) + w1 * bf_lo(b.x) + w2 * bf_lo(c.x), w0 * bf_hi(a.x) + w1 * bf_hi(b.x) + w2 * bf_hi(c.x));
        w.y = cvt_pk_bf16(w0 * bf_lo(a.y) + w1 * bf_lo(b.y) + w2 * bf_lo(c.y), w0 * bf_hi(a.y) + w1 * bf_hi(b.y) + w2 * bf_hi(c.y));
        w.z = cvt_pk_bf16(w0 * bf_lo(a.z) + w1 * bf_lo(b.z) + w2 * bf_lo(c.z), w0 * bf_hi(a.z) + w1 * bf_hi(b.z) + w2 * bf_hi(c.z));
        w.w = cvt_pk_bf16(w0 * bf_lo(a.w) + w1 * bf_lo(b.w) + w2 * bf_lo(c.w), w0 * bf_hi(a.w) + w1 * bf_hi(b.w) + w2 * bf_hi(c.w));
        *(u32x4*)(o + (size_t)t * 1024 + c8 * 8) = w;
    }
}


#define XB_TMO      128
#define XB_XCNT(j)  (256  + 64 * (j))
#define XB_XSUB(j)  (1280 + 64 * (j))
#define XB_XGEN(j)  (2304 + 64 * (j))
#define XB_TOP      3328
#define XB_TOPGEN   3392
#define XCD_BAR_WORDS 3456
#define XB_SPIN_CAP (1u << 22)
__device__ __forceinline__ unsigned xb_ld(unsigned* p)              { return __hip_atomic_load(p, __ATOMIC_RELAXED, __HIP_MEMORY_SCOPE_AGENT); }
__device__ __forceinline__ unsigned xb_add(unsigned* p, unsigned v) { return __hip_atomic_fetch_add(p, v, __ATOMIC_RELAXED, __HIP_MEMORY_SCOPE_AGENT); }
__device__ __forceinline__ unsigned xb_xcc_id() { return (unsigned)__builtin_amdgcn_s_getreg((3 << 11) | 20) & 0xFu; }
#define XB_SPIN(cond, bar) do { unsigned _sp = 0; while (cond) { __builtin_amdgcn_s_sleep(1); \
    if ((++_sp & 255u) == 0u) { if (xb_ld(&(bar)[XB_TMO])) break; if (_sp > XB_SPIN_CAP) { atomicAdd(&(bar)[XB_TMO], 1u); break; } } } } while (0)
__device__ __forceinline__ void xcd_barrier_complete(unsigned* bar, unsigned x, unsigned& nloc, unsigned& nx) {
    const unsigned G = gridDim.x;
    unsigned sum, cnt, mine, sp = 0u;
    for (;;) {
        sum = 0u; cnt = 0u; mine = 0u;
#pragma unroll
        for (unsigned j = 0; j < 16; ++j) { const unsigned c = xb_ld(&bar[XB_XCNT(j)]); sum += c; cnt += (c > 0u) ? 1u : 0u; mine = (j == x) ? c : mine; }
        if (sum == G) break;
        __builtin_amdgcn_s_sleep(1);
        if ((++sp & 255u) == 0u) { if (xb_ld(&bar[XB_TMO])) break; if (sp > XB_SPIN_CAP) { atomicAdd(&bar[XB_TMO], 1u); break; } }
    }
    nloc = mine > 0u ? mine : 1u; nx = cnt > 0u ? cnt : 1u;
}
__device__ __forceinline__ void xcd_barrier(unsigned* bar, volatile LAS unsigned* st) {
    asm volatile("s_waitcnt vmcnt(0)" ::: "memory");
    __syncthreads();
    if (threadIdx.x == 0) {
        const unsigned x = xb_xcc_id();
        __builtin_amdgcn_s_waitcnt(0);
        unsigned nloc = st[0], nx = st[1];
        if (nloc == 0u) { xcd_barrier_complete(bar, x, nloc, nx); st[0] = nloc; st[1] = nx; }
        const unsigned old = xb_add(&bar[XB_XSUB(x)], 1u);
        const unsigned gen = old / nloc;
        if (old + 1u == (gen + 1u) * nloc) {
            __builtin_amdgcn_fence(__ATOMIC_RELEASE, "agent");
            asm volatile("s_waitcnt vmcnt(0)" ::: "memory");
            const unsigned og = xb_add(&bar[XB_TOP], 1u);
            const unsigned tg = og / nx;
            if (og + 1u == (tg + 1u) * nx) xb_add(&bar[XB_TOPGEN], 1u);
            else XB_SPIN(xb_ld(&bar[XB_TOPGEN]) == tg, bar);
            __builtin_amdgcn_fence(__ATOMIC_ACQUIRE, "agent");
            xb_add(&bar[XB_XGEN(x)], 1u);
            asm volatile("s_waitcnt vmcnt(0)" ::: "memory");
        } else {
            XB_SPIN(xb_ld(&bar[XB_XGEN(x)]) == gen, bar);
            __builtin_amdgcn_fence(__ATOMIC_ACQUIRE, "agent");
            asm volatile("s_waitcnt vmcnt(0)" ::: "memory");
        }
    }
    __syncthreads();
}

enum { ST_NORM = 0, ST_GEMM_BF16 = 1, ST_GEMM_RESID = 2, ST_POOL = 3, ST_SGU = 4, ST_ATTN = 5, ST_MERGE = 6 };

__device__ __forceinline__ Params kparams() {
#if defined(__HIP_DEVICE_COMPILE__)
    typedef const __attribute__((address_space(4))) Params* KP;
    KP pp = (KP)__builtin_amdgcn_kernarg_segment_ptr();
    asm volatile("" : "+s"(pp));
    Params r;
    r.x = pp->x; r.norm_mix = pp->norm_mix; r.pool_w_in = pp->pool_w_in; r.pool_w_group = pp->pool_w_group; r.pool_scale = pp->pool_scale; r.pool_w_out = pp->pool_w_out;
    r.sgu_w_in = pp->sgu_w_in; r.sgu_v_norm = pp->sgu_v_norm; r.sgu_w_s = pp->sgu_w_s; r.sgu_b_s = pp->sgu_b_s; r.sgu_w_out = pp->sgu_w_out;
    r.attn_w_qkv = pp->attn_w_qkv; r.attn_w_out = pp->attn_w_out; r.norm_mlp = pp->norm_mlp; r.mlp_w_up = pp->mlp_w_up; r.mlp_w_down = pp->mlp_w_down; r.norm_final = pp->norm_final;
    r.out = pp->out; r.ws = pp->ws;
    return r;
#else
    return Params{};
#endif
}

__global__ void __launch_bounds__(512, 2) fwd_kernel(Params p_unused) {
    extern __shared__ __attribute__((aligned(16))) unsigned char smem[];
    LAS unsigned char* lds = (LAS unsigned char*)smem;
    cg::grid_group grid = cg::this_grid();

    volatile LAS unsigned* bst = (volatile LAS unsigned*)(lds + LDS_BYTES - 16);
    { const Params p0 = kparams();
      unsigned* bar0 = (unsigned*)(p0.ws + OFF_BAR);
      if (blockIdx.x == 0) for (int i = threadIdx.x; i < XCD_BAR_WORDS; i += 512) bar0[i] = 0u;
      if (threadIdx.x == 0) { bst[0] = 0u; bst[1] = 0u; }
      convert_phase(p0, lds); }
    grid.sync();
    { unsigned* bar0 = (unsigned*)(kparams().ws + OFF_BAR); if (threadIdx.x == 0) (void)xb_add(&bar0[XB_XCNT(xb_xcc_id())], 1u); }

    for (int layer = 0; layer < 4; ++layer) {
        const int kind = layer % 3, j = layer / 3;
        const int nsteps = (kind == 1) ? 5 : 6;
        for (int s = 0; s < nsteps; ++s) {
            const Params p = kparams();
            const int mlp0 = nsteps - 2;
            int st;
            if (s == mlp0) st = ST_GEMM_BF16;
            else if (s == mlp0 + 1 || s == mlp0 - 1) st = ST_GEMM_RESID;
            else if (s == 0) st = ST_GEMM_BF16;
            else if (kind == 0) st = (s == 1) ? ST_POOL : ST_GEMM_BF16;
            else if (kind == 1) st = ST_SGU;
            else st = (s == 1) ? ST_ATTN : ST_MERGE;
            float* const SS = (float*)(p.ws + OFF_SS);
            if (st == ST_GEMM_BF16) {
                bf16_t* const W = (bf16_t*)(p.ws + OFF_W);
                pg8::Gemm g; g.M = SEQ; g.A = (const bf16_t*)(p.ws + OFF_H); g.lda = 2048; g.K = 2048; g.agrp = 0;
                pg8::EpiBf16 E; E.O = (bf16_t*)(p.ws + OFF_T1); E.colscale = p.pool_scale; E.vss = (float*)(p.ws + OFF_VSS); E.ss = SS + (size_t)(2 * layer) * SEQ * 32;
                if (s == mlp0) { g.Bt = W + WUP + (size_t)layer * 8192 * 2048; g.N = 8192; E.act = pg8::ACT_RELU2; E.ss = SS + (size_t)(2 * layer + 1) * SEQ * 32; }
                else if (kind == 0 && s == 0) { g.Bt = W + WPI + (size_t)j * 2048 * 2048; g.N = 2048; E.act = pg8::ACT_NONE; }
                else if (kind == 0) { g.A = (const bf16_t*)(p.ws + OFF_T2); g.K = 512; g.agrp = 1; g.Bt = W + WPG + (size_t)j * 2048 * 512; g.N = 2048; E.act = pg8::ACT_COLSCALE; E.colscale = p.pool_scale + j * DM; E.ss = nullptr; }
                else if (kind == 1) { g.Bt = W + WSI; g.N = 4096; E.act = pg8::ACT_GELU_VSS; }
                else { g.Bt = W + WQKV; g.N = 9216; E.act = pg8::ACT_NONE; }
                E.ldc = g.N;
                pg8::StaticOrder so; so.init(SEQ, g.N, gdim_fresh(), bid_fresh());
                pg8::gemm_phase<pg8::EpiBf16>(lds, g, so, E);
            } else if (st == ST_GEMM_RESID) {
                bf16_t* const W = (bf16_t*)(p.ws + OFF_W);
                pg8::Gemm g; g.M = SEQ; g.N = 2048; g.agrp = 0;
                pg8::EpiResid E; E.xin = p.out; E.out = p.out; E.ldc = DM; E.xb = (bf16_t*)(p.ws + OFF_H);
                if (s == mlp0 + 1) { g.A = (const bf16_t*)(p.ws + OFF_T1); g.lda = 8192; g.K = 8192; g.Bt = W + WDN + (size_t)layer * 8192 * 2048; E.ss = (layer < 3) ? SS + (size_t)(2 * layer + 2) * SEQ * 32 : nullptr; }
                else {
                    E.ss = SS + (size_t)(2 * layer + 1) * SEQ * 32;
                    if (kind == 0) { g.A = (const bf16_t*)(p.ws + OFF_T1); g.lda = 2048; g.K = 2048; g.Bt = W + WPO + (size_t)j * 2048 * 2048; if (layer == 0) E.xin = p.x; }
                    else if (kind == 1) { g.A = (const bf16_t*)(p.ws + OFF_T2); g.lda = 2048; g.K = 2048; g.Bt = W + WSO; }
                    else { g.A = (const bf16_t*)(p.ws + OFF_T1); g.lda = 1024; g.K = 1024; g.Bt = W + WAO; }
                }
                pg8::StaticOrder so; so.init(SEQ, g.N, gdim_fresh(), bid_fresh());
                pg8::gemm_phase<pg8::EpiResid>(lds, g, so, E);
            } else if (st == ST_POOL) {
                pool_phase((const bf16_t*)(p.ws + OFF_T1), (bf16_t*)(p.ws + OFF_T2));
            } else if (st == ST_SGU) {
                sgu_phase(p, lds);
            } else if (st == ST_ATTN) {
                attn_phase(p, lds);
            } else {
                merge_phase(p);
            }
            xcd_barrier((unsigned*)(kparams().ws + OFF_BAR), bst);
        }
    }
    { const Params p = kparams(); norm_phase<true>(p.out, p.norm_final, nullptr, p.out); }
}

extern "C" void kernel_launch(void* const* d_in, const int* in_sizes, int n_in, void* d_out, int out_size, void* d_ws, size_t ws_size, hipStream_t stream) {
    static int grid = 0;
    if (grid == 0) {
        if (n_in != 17 || out_size != SEQ * DM || ws_size < WS_END) { fprintf(stderr, "kernel_launch: unexpected shapes (n_in %d, out %d, ws %zu, need %zu)\n", n_in, out_size, ws_size, (size_t)WS_END); grid = -1; return; }
        int dev = 0, cus = 0, per_cu = 0;
        hipGetDevice(&dev);
        hipDeviceGetAttribute(&cus, hipDeviceAttributeMultiprocessorCount, dev);
        if (hipFuncSetAttribute((const void*)fwd_kernel, hipFuncAttributeMaxDynamicSharedMemorySize, (int)LDS_BYTES) != hipSuccess) { fprintf(stderr, "kernel_launch: hipFuncSetAttribute failed\n"); grid = -1; return; }
        if (hipOccupancyMaxActiveBlocksPerMultiprocessor(&per_cu, (const void*)fwd_kernel, 512, LDS_BYTES) != hipSuccess || per_cu < 1) { fprintf(stderr, "kernel_launch: occupancy query gave %d\n", per_cu); per_cu = 1; }
        (void)hipGetLastError();
        grid = cus * per_cu;
    }
    if (grid < 0) return;
    Params p{};
    p.x = (const float*)d_in[0]; p.norm_mix = (const float*)d_in[1]; p.pool_w_in = (const float*)d_in[2]; p.pool_w_group = (const float*)d_in[3];
    p.pool_scale = (const float*)d_in[4]; p.pool_w_out = (const float*)d_in[5]; p.sgu_w_in = (const float*)d_in[6]; p.sgu_v_norm = (const float*)d_in[7];
    p.sgu_w_s = (const float*)d_in[8]; p.sgu_b_s = (const float*)d_in[9]; p.sgu_w_out = (const float*)d_in[10]; p.attn_w_qkv = (const float*)d_in[11];
    p.attn_w_out = (const float*)d_in[12]; p.norm_mlp = (const float*)d_in[13]; p.mlp_w_up = (const float*)d_in[14]; p.mlp_w_down = (const float*)d_in[15];
    p.norm_final = (const float*)d_in[16];
    p.out = (float*)d_out; p.ws = (unsigned char*)d_ws;
    void* args[] = {&p};
    hipError_t e = hipLaunchCooperativeKernel((const void*)fwd_kernel, dim3(grid), dim3(512), args, LDS_BYTES, stream);
    if (e != hipSuccess) fprintf(stderr, "kernel_launch: cooperative launch failed: %s (grid %d)\n", hipGetErrorString(e), grid);
}
```
